# Optimizing an MI355X kernel written in HIP

```python
import jax, jax.numpy as jnp
from jax import lax
import numpy as np

D_MODEL = 1024
BATCH = 2
SEQ = 8192
DEPTH = 4

CHUNK = 64
MIX_WIDTH = D_MODEL
GLA_WIDTH = MIX_WIDTH // 2
GLA_HEADS = 4
GLA_DV = GLA_WIDTH // GLA_HEADS
GLA_DK = GLA_DV // 2
GLA_GATE_RANK = 16
GLA_GATE_TAU = 16.0
SGU_WIDTH = MIX_WIDTH - GLA_WIDTH
SGU_GROUPS = 4
SGU_GROUP_DIM = SGU_WIDTH // SGU_GROUPS
SGU_BLOCK = 128
N_GROUPS = 4
EXPERTS_PER_GROUP = 8
N_EXPERTS = N_GROUPS * EXPERTS_PER_GROUP
TOP_K = 2
EXPERT_FF = D_MODEL // 4
EPS = 1e-6
QK_WIDTH = GLA_HEADS * GLA_DK
IN_COLS = 2 * QK_WIDTH + 2 * GLA_WIDTH + GLA_GATE_RANK + 2 * SGU_WIDTH

kernel_name = "hybrid_gla_sgu_hmoe_adaln"


def rmsnorm(x, g):
    xf = x.astype(jnp.float32)
    r = lax.rsqrt(jnp.mean(xf * xf, axis=-1, keepdims=True) + EPS)
    return (xf * r).astype(x.dtype) * g


def layernorm(x, g, b):
    xf = x.astype(jnp.float32)
    mu = jnp.mean(xf, axis=-1, keepdims=True)
    xc = xf - mu
    var = jnp.mean(xc * xc, axis=-1, keepdims=True)
    return (xc * lax.rsqrt(var + EPS)).astype(x.dtype) * g + b


def modulate(h, shift, scale):
    return h * (1.0 + scale[:, None, :]) + shift[:, None, :]


def gla_chunked(q, k, v, gk):
    out_dtype = v.dtype
    B, L, H, K = q.shape
    V = v.shape[-1]
    n = L // CHUNK
    f32 = jnp.float32
    q = q.astype(f32).reshape(B, n, CHUNK, H, K)
    k = k.astype(f32).reshape(B, n, CHUNK, H, K)
    v = v.astype(f32).reshape(B, n, CHUNK, H, V)
    b = jnp.cumsum(gk.astype(f32).reshape(B, n, CHUNK, H, K), axis=2)
    b_last = b[:, :, -1]
    q_dec = q * jnp.exp(b)
    k_inv = k * jnp.exp(-b)
    k_end = k * jnp.exp(b_last[:, :, None] - b)
    tril = jnp.tril(jnp.ones((CHUNK, CHUNK), dtype=bool))
    att = jnp.einsum('bnihk,bnjhk->bnhij', q_dec, k_inv)
    att = jnp.where(tril, att, 0.0)
    o_intra = jnp.einsum('bnhij,bnjhv->bnihv', att, v)
    kv = jnp.einsum('bnjhk,bnjhv->bnhkv', k_end, v)
    decay = jnp.exp(b_last)

    def step(S, inp):
        dec, kvc = inp
        return dec[..., None] * S + kvc, S

    S0 = jnp.zeros((B, H, K, V), f32)
    _, S_prev = lax.scan(step, S0, (jnp.moveaxis(decay, 1, 0), jnp.moveaxis(kv, 1, 0)))
    S_prev = jnp.moveaxis(S_prev, 0, 1)
    o_inter = jnp.einsum('bnihk,bnhkv->bnihv', q_dec, S_prev)
    return (o_intra + o_inter).reshape(B, L, H, V).astype(out_dtype)


def spatial_gating(z_u, z_v, ln_g, ln_b, w_s, b_s):
    B, L, _ = z_v.shape
    v = layernorm(z_v, ln_g, ln_b)
    v = v.reshape(B, L // SGU_BLOCK, SGU_BLOCK, SGU_GROUPS, SGU_GROUP_DIM)
    pos_chunk = jnp.arange(SGU_BLOCK) // CHUNK
    mask = pos_chunk[None, :] <= pos_chunk[:, None]
    w = jnp.where(mask[None], w_s, 0.0).astype(v.dtype)
    s = jnp.einsum('gij,bnjgc->bnigc', w, v) + jnp.transpose(b_s)[None, None, :, :, None]
    return z_u * s.reshape(B, L, SGU_WIDTH)


def hier_moe(h, wr_g, br_g, wr_e, br_e, w_gate, w_up, w_down):
    B, L, D = h.shape
    t = h.reshape(B * L, D)
    T = t.shape[0]
    g_logits = (t @ wr_g + br_g).astype(jnp.float32)
    g_prob = jax.nn.softmax(g_logits, axis=-1)
    g_idx = jnp.argmax(g_logits, axis=-1)
    g_w = jnp.take_along_axis(g_prob, g_idx[:, None], axis=-1)
    e_logits = (t @ wr_e + br_e).astype(jnp.float32).reshape(T, N_GROUPS, EXPERTS_PER_GROUP)
    e_sel = jnp.take_along_axis(e_logits, g_idx[:, None, None], axis=1)[:, 0]
    top_v, top_i = lax.top_k(e_sel, TOP_K)
    top_w = jax.nn.softmax(top_v, axis=-1) * g_w
    expert_id = g_idx[:, None] * EXPERTS_PER_GROUP + top_i
    combine = jnp.sum(jax.nn.one_hot(expert_id, N_EXPERTS, dtype=jnp.float32) * top_w[..., None], axis=1)
    combine = combine.astype(h.dtype)
    y = jnp.zeros_like(t)
    for g in range(N_GROUPS):
        sl = slice(g * EXPERTS_PER_GROUP, (g + 1) * EXPERTS_PER_GROUP)
        a = jnp.einsum('td,edf->tef', t, w_gate[sl])
        u = jnp.einsum('td,edf->tef', t, w_up[sl])
        act = jax.nn.silu(a) * u * combine[:, sl, None]
        y = y + jnp.einsum('tef,efd->td', act, w_down[sl])
    return y.reshape(B, L, D)


def setup_inputs(seed: int = 0) -> dict:
    key = jax.random.key(seed)
    ks = jax.random.split(key, 32)
    f32 = jnp.float32
    nrm = lambda k, shape, s: jax.random.normal(k, shape, f32) * s
    return {
        "x": nrm(ks[0], (BATCH, SEQ, D_MODEL), 1.0),
        "c": nrm(ks[1], (BATCH, D_MODEL), 1.0),
        "norm1_g": 1.0 + nrm(ks[2], (DEPTH, D_MODEL), 0.01),
        "w_in": nrm(ks[3], (DEPTH, D_MODEL, IN_COLS), D_MODEL ** -0.5),
        "gla_wg2": nrm(ks[4], (DEPTH, GLA_GATE_RANK, QK_WIDTH), GLA_GATE_RANK ** -0.5),
        "gla_bg": nrm(ks[5], (DEPTH, QK_WIDTH), 0.1),
        "gla_onorm_g": 1.0 + nrm(ks[6], (DEPTH, GLA_DV), 0.01),
        "sgu_ln_g": 1.0 + nrm(ks[7], (DEPTH, SGU_WIDTH), 0.01),
        "sgu_ln_b": nrm(ks[8], (DEPTH, SGU_WIDTH), 0.01),
        "sgu_ws": nrm(ks[9], (DEPTH, SGU_GROUPS, SGU_BLOCK, SGU_BLOCK), SGU_BLOCK ** -0.5),
        "sgu_bs": 1.0 + nrm(ks[10], (DEPTH, SGU_GROUPS, SGU_BLOCK), 0.01),
        "sgu_onorm_g": 1.0 + nrm(ks[11], (DEPTH, SGU_GROUPS, SGU_GROUP_DIM), 0.01),
        "w_out": nrm(ks[12], (DEPTH, MIX_WIDTH, D_MODEL), MIX_WIDTH ** -0.5),
        "norm2_g": 1.0 + nrm(ks[13], (DEPTH, D_MODEL), 0.01),
        "router_g_w": nrm(ks[14], (DEPTH, D_MODEL, N_GROUPS), D_MODEL ** -0.5),
        "router_g_b": nrm(ks[15], (DEPTH, N_GROUPS), 0.01),
        "router_e_w": nrm(ks[16], (DEPTH, D_MODEL, N_EXPERTS), D_MODEL ** -0.5),
        "router_e_b": nrm(ks[17], (DEPTH, N_EXPERTS), 0.01),
        "exp_w_gate": nrm(ks[18], (DEPTH, N_EXPERTS, D_MODEL, EXPERT_FF), D_MODEL ** -0.5),
        "exp_w_up": nrm(ks[19], (DEPTH, N_EXPERTS, D_MODEL, EXPERT_FF), D_MODEL ** -0.5),
        "exp_w_down": nrm(ks[20], (DEPTH, N_EXPERTS, EXPERT_FF, D_MODEL), EXPERT_FF ** -0.5),
        "ada_w": nrm(ks[21], (DEPTH, D_MODEL, 6 * D_MODEL), 0.5 * D_MODEL ** -0.5),
        "ada_b": nrm(ks[22], (DEPTH, 6 * D_MODEL), 0.02),
        "final_g": 1.0 + nrm(ks[23], (D_MODEL,), 0.01),
    }


def reference(x, c, norm1_g, w_in, gla_wg2, gla_bg, gla_onorm_g, sgu_ln_g, sgu_ln_b, sgu_ws,
              sgu_bs, sgu_onorm_g, w_out, norm2_g, router_g_w, router_g_b, router_e_w,
              router_e_b, exp_w_gate, exp_w_up, exp_w_down, ada_w, ada_b, final_g):
    B, L, D = x.shape
    split_at = list(np.cumsum([QK_WIDTH, QK_WIDTH, GLA_WIDTH, GLA_WIDTH, GLA_GATE_RANK, SGU_WIDTH]))
    c_act = jax.nn.silu(c)
    for l in range(DEPTH):
        mod = c_act @ ada_w[l] + ada_b[l]
        sh1, sc1, gt1, sh2, sc2, gt2 = jnp.split(mod, 6, axis=-1)
        h = modulate(rmsnorm(x, norm1_g[l]), sh1, sc1)
        p = h @ w_in[l]
        p_q, p_k, p_v, p_og, p_glow, p_u, p_sv = jnp.split(p, [int(i) for i in split_at], axis=-1)
        q = p_q.reshape(B, L, GLA_HEADS, GLA_DK) * (GLA_DK ** -0.5)
        k = p_k.reshape(B, L, GLA_HEADS, GLA_DK)
        v = p_v.reshape(B, L, GLA_HEADS, GLA_DV)
        gk = jax.nn.log_sigmoid((p_glow @ gla_wg2[l] + gla_bg[l]).astype(jnp.float32)) / GLA_GATE_TAU
        gk = gk.reshape(B, L, GLA_HEADS, GLA_DK)
        o_gla = gla_chunked(q, k, v, gk)
        o_gla = rmsnorm(o_gla, gla_onorm_g[l]).reshape(B, L, GLA_WIDTH) * jax.nn.silu(p_og)
        o_sgu = spatial_gating(jax.nn.gelu(p_u), jax.nn.gelu(p_sv), sgu_ln_g[l], sgu_ln_b[l],
                               sgu_ws[l], sgu_bs[l])
        o_sgu = rmsnorm(o_sgu.reshape(B, L, SGU_GROUPS, SGU_GROUP_DIM), sgu_onorm_g[l]).reshape(B, L, SGU_WIDTH)
        y = jnp.concatenate([o_gla, o_sgu], axis=-1) @ w_out[l]
        x = x + gt1[:, None, :] * y
        h2 = modulate(rmsnorm(x, norm2_g[l]), sh2, sc2)
        m = hier_moe(h2, router_g_w[l], router_g_b[l], router_e_w[l], router_e_b[l],
                     exp_w_gate[l], exp_w_up[l], exp_w_down[l])
        x = x + gt2[:, None, :] * m
    return rmsnorm(x, final_g)
```

```cpp
#include <hip/hip_runtime.h>
#include <cstdio>
#include <cstdint>

#ifndef MK_SPLIT
#define MK_SPLIT 0
#endif

#define LAS __attribute__((address_space(3)))
#define CAS __attribute__((address_space(4)))
#define GAS __attribute__((address_space(1)))
typedef unsigned short bf16_t;
typedef short bf16x8 __attribute__((ext_vector_type(8)));
typedef float f32x4 __attribute__((ext_vector_type(4)));
typedef float f32x2 __attribute__((ext_vector_type(2)));
typedef unsigned u32x4 __attribute__((ext_vector_type(4)));
typedef unsigned u32x2 __attribute__((ext_vector_type(2)));

constexpr int D = 1024, SEQ = 8192, T = 16384, DEPTH = 4, NWAVES = 8;
constexpr int INC = 2576;
constexpr int NP = 2816;
constexpr int PQ = 0, PK = 256, PG = 512, PV = 768, POG = 1280, PU = 1792, PSV = 2304;
constexpr int NCH = 256;
constexpr float EPS = 1e-6f;
constexpr int NPH = 2 + 9 * DEPTH;

constexpr size_t MiB = 1u << 20;
constexpr size_t WS_CTL = 0, CTL_ZERO_BYTES = 1 * MiB;
constexpr size_t WS_MOD = 1 * MiB;
constexpr size_t WS_WRT = 2 * MiB;
constexpr size_t WS_TOK = 3 * MiB;
constexpr size_t WS_WL = 5 * MiB;
constexpr size_t WS_REF = 7 * MiB;
constexpr size_t WS_DECAY = 8 * MiB;
constexpr size_t WS_WIN = 10 * MiB;
constexpr size_t WS_WOUT = 32 * MiB;
constexpr size_t WS_WGU = 40 * MiB;
constexpr size_t WS_WD = 168 * MiB;
constexpr size_t WS_H = 232 * MiB;
constexpr size_t WS_P = 264 * MiB;
constexpr size_t WS_Y = 264 * MiB;
constexpr size_t WS_KVT = 352 * MiB;
constexpr size_t WS_ACT = 352 * MiB;
constexpr size_t WS_ST = 384 * MiB;
constexpr size_t WS_OMIX = 400 * MiB;
constexpr size_t WS_END = 432 * MiB;
constexpr int CW_BAR = 4096;
constexpr int CW_CNT = 16384;

constexpr int RING_BYTES = 131072;
constexpr int MISC_OFF = RING_BYTES;
constexpr int LDS_BYTES = 147456;

__device__ __forceinline__ float bf2f(bf16_t v) { return __builtin_bit_cast(float, (unsigned)v << 16); }
__device__ __forceinline__ unsigned cvt_pk_bf16(float lo, float hi) { unsigned r; asm volatile("v_cvt_pk_bf16_f32 %0, %1, %2" : "=v"(r) : "v"(lo), "v"(hi)); return r; }
__device__ __forceinline__ bf16_t f2bf(float f) { return (bf16_t)(cvt_pk_bf16(f, 0.f) & 0xffffu); }
__device__ __forceinline__ float wave_sum(float v) {
#pragma unroll
    for (int o = 1; o < 64; o <<= 1) v += __shfl_xor(v, o);
    return v;
}
__device__ __forceinline__ float silu_f(float x) { return x * __builtin_amdgcn_rcpf(1.f + __expf(-x)); }
__device__ __forceinline__ float gelu_tanh_f(float x) { const float u = 0.7978845608028654f * (x + 0.044715f * x * x * x); return x * __builtin_amdgcn_rcpf(1.f + __expf(-2.f * u)); }
__device__ __forceinline__ float logsig_f(float z) { return fminf(z, 0.f) - __logf(1.f + __expf(-fabsf(z))); }
#define LDS_WAIT() asm volatile("s_waitcnt lgkmcnt(0)" ::: "memory")
__device__ __forceinline__ const char* uni_ptr(const char* p) {
    unsigned long long v = (unsigned long long)p; unsigned lo = __builtin_amdgcn_readfirstlane((unsigned)v), hi = __builtin_amdgcn_readfirstlane((unsigned)(v >> 32));
    return (const char*)(((unsigned long long)hi << 32) | lo);
}

namespace pg8 {
constexpr int BM = 256, BK = 64, HALF = 128, HTB = HALF * BK * 2, STAGE_BYTES = 8 * HTB, NXCD = 8, WGM = 8;
__host__ __device__ __forceinline__ int lds_byte(int r, int c) { const int st = (r >> 4) * 2 + (c >> 5), rr = r & 15, cc = c & 31, ob = rr * 64 + cc * 2; return st * 1024 + (ob ^ (((ob >> 9) & 1) << 5)); }
__host__ __device__ __forceinline__ void stage_rc(int b, int& R, int& C) { const int st = b / 1024, sb = b % 1024, swz = sb ^ (((sb >> 9) & 1) << 5); R = (st >> 1) * 16 + swz / 64; C = (st & 1) * 32 + (swz % 64) / 2; }
__host__ __device__ __forceinline__ int perm32(int rho) { const int n = rho >> 4, i = rho & 15; return 8 * (i >> 2) + 4 * n + (i & 3); }

struct Unit { int arow, brow, row0, col0, nvalid, toff; };

struct DenseSched {
    static constexpr bool GATHER = false;
    const char* A; const char* B; const int* tok; int nM, nN, nwg, G, c;
    __device__ void init(const void* A_, const void* Bt_, int M, int N, int G_, int c_) { A = (const char*)A_; B = (const char*)Bt_; tok = nullptr; nM = M / BM; nN = N / BM; nwg = nM * nN; G = G_; c = c_; }
    __device__ __forceinline__ bool next(int i, Unit& u) const {
        const long L = (long)i * G + c; if (L >= nwg) return false;
        int wgid = (int)L; { const int q = nwg / NXCD, r = nwg % NXCD, xcd = wgid % NXCD, off = wgid / NXCD; wgid = (xcd < r ? xcd * (q + 1) : r * (q + 1) + (xcd - r) * q) + off; }
        const int nig = WGM * nN, gid = wgid / nig, fm = gid * WGM, gsz = (nM - fm) < WGM ? (nM - fm) : WGM;
        const int pm = fm + ((wgid % nig) % gsz), pn = (wgid % nig) / gsz;
        u.arow = pm * BM; u.brow = pn * BM; u.row0 = pm * BM; u.col0 = pn * BM; u.nvalid = BM; u.toff = 0; return true;
    }
};

template <class Epi, class Sched>
__device__ __forceinline__ void gemm_phase(LAS unsigned char* lds, const int tid, const int K, const Sched& S, const Epi& E) {
    const int wid = __builtin_amdgcn_readfirstlane(tid >> 6), lane = tid & 63, wr = wid >> 2, wc = wid & 3, fr = lane & 15, fq = lane >> 4;
    const int nt = K / BK;
    int stR[2], stC[2]; unsigned voffB[2];
#pragma unroll
    for (int i = 0; i < 2; ++i) { int R, C; stage_rc(tid * 16 + i * 8192, R, C); stR[i] = R; stC[i] = C; const int Rb = Epi::PERM ? ((R & ~31) + perm32(R & 31)) : R; voffB[i] = (unsigned)(Rb * K + C) * 2u; }
    const size_t kstep = (size_t)(BK * 2);
    const size_t hstep = (size_t)HALF * K * 2;
    const unsigned ldsw = (unsigned)wid * 1024u;
    const int aoff = lds_byte(wr * 64 + fr, fq * 8), boff = lds_byte(wc * 32 + fr, fq * 8);
#define PG8_SA(b, h) (((b) * 2 + (h)) * HTB)
#define PG8_SB(b, h) ((4 + (b) * 2 + (h)) * HTB)
#define PG8_STAGE(bufoff, gbase, voff) do { _Pragma("unroll") for (int _i = 0; _i < 2; ++_i) \
        __builtin_amdgcn_global_load_lds((const unsigned*)((const char*)(gbase) + (voff)[_i]), (LAS unsigned*)(lds + (bufoff) + ldsw + _i * 8192), 16, 0, 0); } while (0)
#define PG8_LDA(dst, b, h) do { _Pragma("unroll") for (int m = 0; m < 4; ++m) _Pragma("unroll") for (int k = 0; k < 2; ++k) dst[m][k] = *(const LAS bf16x8*)(lds + PG8_SA(b, h) + aoff + m * 2048 + k * 1024); } while (0)
#define PG8_LDB(dst, b, h) do { _Pragma("unroll") for (int n = 0; n < 2; ++n) _Pragma("unroll") for (int k = 0; k < 2; ++k) dst[n][k] = *(const LAS bf16x8*)(lds + PG8_SB(b, h) + boff + n * 2048 + k * 1024); } while (0)
#define PG8_MMA(ai, bj, At, Bt) do { __builtin_amdgcn_s_setprio(1); _Pragma("unroll") for (int m = 0; m < 4; ++m) _Pragma("unroll") for (int n = 0; n < 2; ++n) _Pragma("unroll") for (int k = 0; k < 2; ++k) \
        acc[ai][bj][m][n] = __builtin_amdgcn_mfma_f32_16x16x32_bf16(Bt[n][k], At[m][k], acc[ai][bj][m][n], 0, 0, 0); __builtin_amdgcn_s_setprio(0); } while (0)
#define PG8_WAIT_V(n) asm volatile("s_waitcnt vmcnt(" #n ")" ::: "memory")
#define PG8_WAIT_L(n) asm volatile("s_waitcnt lgkmcnt(" #n ")" ::: "memory")
#define PG8_BAR __builtin_amdgcn_s_barrier()
#define PG8_SCHED __builtin_amdgcn_sched_barrier(0)
#define PG8_MKVA(u, v) do { _Pragma("unroll") for (int _h = 0; _h < 2; ++_h) _Pragma("unroll") for (int _i = 0; _i < 2; ++_i) { \
        if constexpr (Sched::GATHER) { const int _idx = _h * HALF + stR[_i]; const int _tk = (_idx < (u).nvalid) ? S.tok[(u).toff + _idx] : 0; (v)[_h][_i] = (unsigned)_tk * (unsigned)(K * 2) + (unsigned)(stC[_i] * 2); } \
        else (v)[_h][_i] = (unsigned)(_h * (int)hstep) + (unsigned)(stR[_i] * K + stC[_i]) * 2u; } } while (0)
    Unit cur, nxt; int ui = 0;
    if (!S.next(0, cur)) return;
    f32x4 acc[2][2][4][2];
#pragma unroll
    for (int a = 0; a < 2; ++a)
#pragma unroll
        for (int b = 0; b < 2; ++b)
#pragma unroll
            for (int m = 0; m < 4; ++m)
#pragma unroll
                for (int n = 0; n < 2; ++n) acc[a][b][m][n] = (f32x4){0.f, 0.f, 0.f, 0.f};
    bf16x8 At[4][2], B0[2][2], B1[2][2];
    unsigned vAc[2][2], vAn[2][2];
    PG8_MKVA(cur, vAc);
#define PG8_UA(u) (Sched::GATHER ? S.A : S.A + (size_t)(u).arow * (size_t)(K * 2))
#define PG8_UB(u) (S.B + (size_t)(u).brow * (size_t)(K * 2))
    const char* cA = uni_ptr(PG8_UA(cur)); const char* cB = uni_ptr(PG8_UB(cur));
    PG8_STAGE(PG8_SB(0, 0), cB, voffB); PG8_STAGE(PG8_SB(0, 1), cB + hstep, voffB); PG8_STAGE(PG8_SA(0, 0), cA, vAc[0]); PG8_STAGE(PG8_SA(0, 1), cA, vAc[1]);
    if (wr == 1) PG8_BAR;
    PG8_WAIT_V(2); PG8_BAR;
    PG8_STAGE(PG8_SB(1, 0), cB + kstep, voffB); PG8_STAGE(PG8_SA(1, 0), cA + kstep, vAc[0]); PG8_STAGE(PG8_SB(1, 1), cB + hstep + kstep, voffB);
    PG8_WAIT_V(6); PG8_BAR;
    for (;;) {
        const bool has_next = S.next(ui + 1, nxt);
        if (has_next) { PG8_MKVA(nxt, vAn); }
        else {
#pragma unroll
            for (int h = 0; h < 2; ++h)
#pragma unroll
                for (int i = 0; i < 2; ++i) vAn[h][i] = vAc[h][i];
        }
        const char* nA = has_next ? uni_ptr(PG8_UA(nxt)) : cA; const char* nB = has_next ? uni_ptr(PG8_UB(nxt)) : cB;
#pragma nounroll
        for (int t = 0; t < nt; t += 2) {
            const bool last = (t == nt - 2);
            const char* a1 = cA + (size_t)(t + 1) * kstep;
            const char* a2 = last ? nA : cA + (size_t)(t + 2) * kstep; const char* b2 = last ? nB : cB + (size_t)(t + 2) * kstep;
            const char* a3 = a2 + kstep; const char* b3 = b2 + kstep;
            unsigned v2[2][2];
#pragma unroll
            for (int h = 0; h < 2; ++h)
#pragma unroll
                for (int i = 0; i < 2; ++i) v2[h][i] = last ? vAn[h][i] : vAc[h][i];
            PG8_LDB(B0, 0, 0); PG8_LDB(B1, 0, 1); PG8_SCHED; PG8_LDA(At, 0, 0); PG8_STAGE(PG8_SA(1, 1), a1, vAc[1]);
            PG8_WAIT_V(8); PG8_WAIT_L(0); PG8_BAR; PG8_MMA(0, 0, At, B0); PG8_MMA(0, 1, At, B1); PG8_BAR; PG8_SCHED;
            PG8_LDA(At, 0, 1); PG8_STAGE(PG8_SB(0, 0), b2, voffB); PG8_STAGE(PG8_SB(0, 1), b2 + hstep, voffB); PG8_STAGE(PG8_SA(0, 0), a2, v2[0]);
            PG8_WAIT_V(8); PG8_WAIT_L(0); PG8_BAR; PG8_MMA(1, 0, At, B0); PG8_MMA(1, 1, At, B1); PG8_BAR; PG8_SCHED;
            PG8_LDB(B0, 1, 0); PG8_LDB(B1, 1, 1); PG8_SCHED; PG8_LDA(At, 1, 0); PG8_STAGE(PG8_SA(0, 1), a2, v2[1]);
            PG8_WAIT_V(8); PG8_WAIT_L(0); PG8_BAR; PG8_MMA(0, 0, At, B0); PG8_MMA(0, 1, At, B1); PG8_BAR; PG8_SCHED;
            PG8_LDA(At, 1, 1); PG8_STAGE(PG8_SB(1, 0), b3, voffB); PG8_STAGE(PG8_SB(1, 1), b3 + hstep, voffB); PG8_STAGE(PG8_SA(1, 0), a3, v2[0]);
            PG8_WAIT_V(8); PG8_WAIT_L(0); PG8_BAR; PG8_MMA(1, 0, At, B0); PG8_MMA(1, 1, At, B1); PG8_BAR; PG8_SCHED;
        }
        if (wr == 0) PG8_BAR;
        E(acc, cur, wr, wc, fr, fq);
        if (!has_next) break;
#pragma unroll
        for (int a = 0; a < 2; ++a)
#pragma unroll
            for (int b = 0; b < 2; ++b)
#pragma unroll
                for (int m = 0; m < 4; ++m)
#pragma unroll
                    for (int n = 0; n < 2; ++n) acc[a][b][m][n] = (f32x4){0.f, 0.f, 0.f, 0.f};
        cur = nxt; cA = nA; cB = nB; ++ui;
#pragma unroll
        for (int h = 0; h < 2; ++h)
#pragma unroll
            for (int i = 0; i < 2; ++i) vAc[h][i] = vAn[h][i];
        if (wr == 1) PG8_BAR;
    }
    PG8_WAIT_V(0);
    PG8_BAR;
#undef PG8_SA
#undef PG8_SB
#undef PG8_STAGE
#undef PG8_LDA
#undef PG8_LDB
#undef PG8_MMA
#undef PG8_WAIT_V
#undef PG8_WAIT_L
#undef PG8_BAR
#undef PG8_SCHED
#undef PG8_MKVA
#undef PG8_UA
#undef PG8_UB
}
}

#define XB_TMO      128
#define XB_XCNT(j)  (256  + 64 * (j))
#define XB_XSUB(j)  (1280 + 64 * (j))
#define XB_XGEN(j)  (2304 + 64 * (j))
#define XB_TOP      3328
#define XB_TOPGEN   3392
#define XCD_BAR_WORDS 3456
#define XB_SPIN_CAP (1u << 18)
__device__ __forceinline__ unsigned xb_ld(unsigned* p)              { return __hip_atomic_load(p, __ATOMIC_RELAXED, __HIP_MEMORY_SCOPE_AGENT); }
__device__ __forceinline__ unsigned xb_add(unsigned* p, unsigned v) { return __hip_atomic_fetch_add(p, v, __ATOMIC_RELAXED, __HIP_MEMORY_SCOPE_AGENT); }
__device__ __forceinline__ unsigned xb_xcc_id() { return (unsigned)__builtin_amdgcn_s_getreg((3 << 11) | 20) & 0xFu; }
#define XB_SPIN(cond, bar) do { unsigned _sp = 0; while (cond) { __builtin_amdgcn_s_sleep(1); \
    if ((++_sp & 255u) == 0u) { if (xb_ld(&(bar)[XB_TMO])) break; if (_sp > XB_SPIN_CAP) { atomicAdd(&(bar)[XB_TMO], 1u); break; } } } } while (0)
struct XcdBarrier { unsigned* bar; unsigned x; volatile LAS unsigned* st; };
__device__ __forceinline__ XcdBarrier xcd_barrier_post(unsigned* bar, volatile LAS unsigned* st) {
    XcdBarrier b; b.bar = bar; b.x = xb_xcc_id(); b.st = st;
    if (threadIdx.x == 0) (void)xb_add(&bar[XB_XCNT(b.x)], 1u);
    return b;
}
__device__ __forceinline__ void xcd_barrier_complete(unsigned* bar, unsigned x, unsigned& nloc, unsigned& nx) {
    const unsigned G = gridDim.x * gridDim.y * gridDim.z;
    unsigned sum, cnt, mine, sp = 0u;
    for (;;) {
        sum = 0u; cnt = 0u; mine = 0u;
#pragma unroll
        for (unsigned j = 0; j < 16; ++j) { const unsigned c = xb_ld(&bar[XB_XCNT(j)]); sum += c; cnt += (c > 0u) ? 1u : 0u; mine = (j == x) ? c : mine; }
        if (sum == G) break;
        __builtin_amdgcn_s_sleep(1);
        if ((++sp & 255u) == 0u) { if (xb_ld(&bar[XB_TMO])) break; if (sp > XB_SPIN_CAP) { atomicAdd(&bar[XB_TMO], 1u); break; } }
    }
    nloc = mine > 0u ? mine : 1u; nx = cnt > 0u ? cnt : 1u;
}
__device__ __forceinline__ void xcd_barrier(const XcdBarrier& b) {
    asm volatile("s_waitcnt vmcnt(0)" ::: "memory");
    __syncthreads();
    if (threadIdx.x == 0) {
        unsigned* bar = b.bar;
        __builtin_amdgcn_s_waitcnt(0);
        unsigned nloc = b.st[0], nx = b.st[1];
        if (nloc == 0u) { xcd_barrier_complete(bar, b.x, nloc, nx); b.st[0] = nloc; b.st[1] = nx; }
        const unsigned old = xb_add(&bar[XB_XSUB(b.x)], 1u);
        const unsigned gen = old / nloc;
        if (old + 1u == (gen + 1u) * nloc) {
            __builtin_amdgcn_fence(__ATOMIC_RELEASE, "agent");
            asm volatile("s_waitcnt vmcnt(0)" ::: "memory");
            const unsigned og = xb_add(&bar[XB_TOP], 1u);
            const unsigned tg = og / nx;
            if (og + 1u == (tg + 1u) * nx) xb_add(&bar[XB_TOPGEN], 1u);
            else XB_SPIN(xb_ld(&bar[XB_TOPGEN]) == tg, bar);
            __builtin_amdgcn_fence(__ATOMIC_ACQUIRE, "agent");
            xb_add(&bar[XB_XGEN(b.x)], 1u);
            asm volatile("s_waitcnt vmcnt(0)" ::: "memory");
        } else {
            XB_SPIN(xb_ld(&bar[XB_XGEN(b.x)]) == gen, bar);
            __builtin_amdgcn_fence(__ATOMIC_ACQUIRE, "agent");
            asm volatile("s_waitcnt vmcnt(0)" ::: "memory");
        }
    }
    __syncthreads();
}

struct Args { const float* in[24]; float* out; unsigned char* ws; int ph_lo, ph_hi; };
enum { I_X = 0, I_C, I_N1G, I_WIN, I_WG2, I_BG, I_GONG, I_LNG, I_LNB, I_SWS, I_SBS, I_SONG, I_WOUT, I_N2G, I_RGW, I_RGB, I_REW, I_REB, I_EWG, I_EWU, I_EWD, I_ADAW, I_ADAB, I_FING };

struct Ctx {
    LAS unsigned char* lds;
    int tid, lane, wave, G, bid;
    const float* const* in;
    unsigned char* ws;
    float* out;
};

struct EpiInProj {
    static constexpr bool PERM = true;
    bf16_t* P; const float* bg;
    template <int MODE> __device__ __forceinline__ void run(const f32x4 (&acc)[2][2][4][2], const pg8::Unit& u, int wr, int wc, int fr, int fq) const {
        const int row0 = u.row0 + wr * 64 + fr, col0 = u.col0 + wc * 32 + 8 * fq;
        f32x4 bv[2][2];
#pragma unroll
        for (int bj = 0; bj < 2; ++bj)
#pragma unroll
            for (int n = 0; n < 2; ++n) bv[bj][n] = (MODE == 2) ? *(const f32x4*)(bg + (col0 - PG) + bj * 128 + 4 * n) : (f32x4){0.f, 0.f, 0.f, 0.f};
#pragma unroll
        for (int ai = 0; ai < 2; ++ai)
#pragma unroll
            for (int m = 0; m < 4; ++m) {
                bf16_t* rowp = P + (size_t)(row0 + ai * 128 + m * 16) * NP + col0;
#pragma unroll
                for (int bj = 0; bj < 2; ++bj) {
                    float v[8];
#pragma unroll
                    for (int n = 0; n < 2; ++n)
#pragma unroll
                        for (int j = 0; j < 4; ++j) {
                            float x = acc[ai][bj][m][n][j];
                            if (MODE == 0) x *= 0.125f;
                            else if (MODE == 2) x = logsig_f(x + bv[bj][n][j]) * 0.0625f;
                            else if (MODE == 3) x = silu_f(x);
                            else if (MODE == 4) x = gelu_tanh_f(x);
                            v[n * 4 + j] = x;
                        }
                    u32x4 w; w.x = cvt_pk_bf16(v[0], v[1]); w.y = cvt_pk_bf16(v[2], v[3]); w.z = cvt_pk_bf16(v[4], v[5]); w.w = cvt_pk_bf16(v[6], v[7]);
                    *(u32x4*)(rowp + bj * 128) = w;
                }
            }
    }
    __device__ __forceinline__ void operator()(const f32x4 (&acc)[2][2][4][2], const pg8::Unit& u, int wr, int wc, int fr, int fq) const {
        const int pn = u.col0 >> 8;
        if (pn == 0) run<0>(acc, u, wr, wc, fr, fq);
        else if (pn == 2) run<2>(acc, u, wr, wc, fr, fq);
        else if (pn == 5 || pn == 6) run<3>(acc, u, wr, wc, fr, fq);
        else if (pn >= 7) run<4>(acc, u, wr, wc, fr, fq);
        else run<1>(acc, u, wr, wc, fr, fq);
    }
};

struct EpiOutProj {
    static constexpr bool PERM = true;
    const float* xin; float* xout; const float* gate;
    __device__ __forceinline__ void operator()(const f32x4 (&acc)[2][2][4][2], const pg8::Unit& u, int wr, int wc, int fr, int fq) const {
        const int row0 = u.row0 + wr * 64 + fr, col0 = u.col0 + wc * 32 + 8 * fq;
        const float* g = gate + (u.row0 >= SEQ ? 6144 : 0) + col0;
        f32x4 gv[2][2];
#pragma unroll
        for (int bj = 0; bj < 2; ++bj)
#pragma unroll
            for (int n = 0; n < 2; ++n) gv[bj][n] = *(const f32x4*)(g + bj * 128 + 4 * n);
#pragma unroll
        for (int ai = 0; ai < 2; ++ai)
#pragma unroll
            for (int m = 0; m < 4; ++m) {
                const size_t off = (size_t)(row0 + ai * 128 + m * 16) * D + col0;
#pragma unroll
                for (int bj = 0; bj < 2; ++bj)
#pragma unroll
                    for (int n = 0; n < 2; ++n) {
                        const f32x4 xo = *(const f32x4*)(xin + off + bj * 128 + 4 * n);
                        *(f32x4*)(xout + off + bj * 128 + 4 * n) = xo + gv[bj][n] * acc[ai][bj][m][n];
                    }
            }
    }
};

struct EpiMoe1 {
    static constexpr bool PERM = true;
    bf16_t* ACT; const float* wl;
    __device__ __forceinline__ void operator()(const f32x4 (&acc)[2][2][4][2], const pg8::Unit& u, int wr, int wc, int fr, int fq) const {
        const int col0 = u.col0 + wc * 32 + 8 * fq;
#pragma unroll
        for (int ai = 0; ai < 2; ++ai)
#pragma unroll
            for (int m = 0; m < 4; ++m) {
                const int rt = ai * 128 + wr * 64 + m * 16 + fr;
                if (rt < u.nvalid) {
                    const float w = wl[u.toff + rt];
                    float v[8];
#pragma unroll
                    for (int n = 0; n < 2; ++n)
#pragma unroll
                        for (int j = 0; j < 4; ++j) v[n * 4 + j] = silu_f(acc[ai][0][m][n][j]) * acc[ai][1][m][n][j] * w;
                    u32x4 o; o.x = cvt_pk_bf16(v[0], v[1]); o.y = cvt_pk_bf16(v[2], v[3]); o.z = cvt_pk_bf16(v[4], v[5]); o.w = cvt_pk_bf16(v[6], v[7]);
                    *(u32x4*)(ACT + (size_t)(u.row0 + rt) * 256 + col0) = o;
                }
            }
    }
};

struct EpiMoe2 {
    static constexpr bool PERM = true;
    bf16_t* Y;
    __device__ __forceinline__ void operator()(const f32x4 (&acc)[2][2][4][2], const pg8::Unit& u, int wr, int wc, int fr, int fq) const {
        const int col0 = u.col0 + wc * 32 + 8 * fq;
#pragma unroll
        for (int ai = 0; ai < 2; ++ai)
#pragma unroll
            for (int m = 0; m < 4; ++m) {
                const int rt = ai * 128 + wr * 64 + m * 16 + fr;
                if (rt < u.nvalid) {
                    bf16_t* rowp = Y + (size_t)(u.row0 + rt) * D + col0;
#pragma unroll
                    for (int bj = 0; bj < 2; ++bj) {
                        const f32x4 v0 = acc[ai][bj][m][0], v1 = acc[ai][bj][m][1];
                        u32x4 o; o.x = cvt_pk_bf16(v0[0], v0[1]); o.y = cvt_pk_bf16(v0[2], v0[3]); o.z = cvt_pk_bf16(v1[0], v1[1]); o.w = cvt_pk_bf16(v1[2], v1[3]);
                        *(u32x4*)(rowp + bj * 128) = o;
                    }
                }
            }
    }
};

struct MoeTables { const LAS int* tp; const LAS int* cnt; const LAS int* base; const LAS int* ue; };
#define RFL(x) __builtin_amdgcn_readfirstlane(x)
struct MoeSched1 {
    static constexpr bool GATHER = true;
    MoeTables tb; const char* A; const char* B; const int* tok; int G, c;
    __device__ __forceinline__ bool next(int i, pg8::Unit& u) const {
        if (i >= 16) return false;
        const int e = RFL(tb.ue[i]); if (e < 0) return false;
        const int L = i * G + c, tile = L >> 1, nt = L & 1;
        const int mt = tile - RFL(tb.tp[e]); const int nv = RFL(tb.cnt[e]) - mt * 256;
        u.arow = 0; u.brow = e * 512 + nt * 256; u.row0 = RFL(tb.base[e]) + mt * 256; u.col0 = nt * 128; u.nvalid = nv < 256 ? nv : 256; u.toff = e * T + mt * 256; return true;
    }
};
struct MoeSched2 {
    static constexpr bool GATHER = false;
    MoeTables tb; const char* A; const char* B; const int* tok; int G, c;
    __device__ __forceinline__ bool next(int i, pg8::Unit& u) const {
        if (i >= 16) return false;
        const int e = RFL(tb.ue[i]); if (e < 0) return false;
        const int L = i * G + c, tile = L >> 2, nt = L & 3;
        const int mt = tile - RFL(tb.tp[e]); const int nv = RFL(tb.cnt[e]) - mt * 256;
        u.row0 = RFL(tb.base[e]) + mt * 256; u.arow = u.row0; u.brow = e * 1024 + nt * 256; u.col0 = nt * 256; u.nvalid = nv < 256 ? nv : 256; u.toff = 0; return true;
    }
};

__global__ void __launch_bounds__(NWAVES * 64, 2) fwd_kernel(Args args) {
    extern __shared__ __attribute__((aligned(16))) unsigned char lds_raw[];
    LAS unsigned char* lds = (LAS unsigned char*)lds_raw;
    const int tid0 = threadIdx.x, G0 = gridDim.x, bid0 = blockIdx.x;
#define PHASE_BEGIN() \
    int tid = tid0, bid = bid0, G = G0, l = l0; \
    asm volatile("" : "+v"(tid), "+s"(bid), "+s"(G), "+s"(l) :: "memory"); KSEG_FENCE(); \
    const int lane = tid & 63, wave = __builtin_amdgcn_readfirstlane(tid >> 6), gw = bid * NWAVES + wave, NGW = G * NWAVES; \
    const float* modl = MOD + (size_t)l * 2 * 6144; (void)lane; (void)wave; (void)gw; (void)NGW; (void)modl
    const CAS unsigned char* kseg = (const CAS unsigned char*)__builtin_amdgcn_kernarg_segment_ptr();
#define KSEG_FENCE() asm volatile("" : "+s"(kseg) :: "memory")
#define KIN(i) (*(const float* const CAS*)(kseg + 8 * (i)))
#define K_OUT (*(float* const CAS*)(kseg + 192))
#define K_WS (*(unsigned char* const CAS*)(kseg + 200))
#define WSP(type, off) ((type*)(K_WS + (off)))
#define ctl WSP(unsigned, WS_CTL)
#define MOD WSP(float, WS_MOD)
#define WRT WSP(float, WS_WRT)
#define TOK WSP(int, WS_TOK)
#define WL WSP(float, WS_WL)
#define REF WSP(int, WS_REF)
#define DECAY WSP(float, WS_DECAY)
#define WIN WSP(bf16_t, WS_WIN)
#define WOUT WSP(bf16_t, WS_WOUT)
#define WGU WSP(bf16_t, WS_WGU)
#define WD WSP(bf16_t, WS_WD)
#define H WSP(bf16_t, WS_H)
#define P WSP(bf16_t, WS_P)
#define Y WSP(bf16_t, WS_Y)
#define KVT WSP(float, WS_KVT)
#define ACT WSP(bf16_t, WS_ACT)
#define ST WSP(bf16_t, WS_ST)
#define OMIX WSP(bf16_t, WS_OMIX)
#define XOUT K_OUT
    volatile LAS unsigned* MISC = (volatile LAS unsigned*)(lds + MISC_OFF);
    LAS int* TB_TP = (LAS int*)(lds + MISC_OFF + 64);
    LAS int* TB_CNT = (LAS int*)(lds + MISC_OFF + 256);
    LAS int* TB_BASE = (LAS int*)(lds + MISC_OFF + 448);
    LAS int* TB_UE = (LAS int*)(lds + MISC_OFF + 640);

    for (int u = tid0; u < 256; u += NWAVES * 64) ((LAS unsigned*)(lds + MISC_OFF))[u] = 0u;
    __syncthreads();
    unsigned my_xcc = 0;
    if (!MK_SPLIT) { XcdBarrier b0 = xcd_barrier_post(ctl + CW_BAR, MISC + 0); my_xcc = b0.x; }
    const int lo = *(const int CAS*)(kseg + 208), hi = *(const int CAS*)(kseg + 212);
#ifndef PHMASK
#define PHMASK 0x7ff
#endif
#define PHT(k) ((k) < 2 ? (k) : 2 + ((k) - 2) % 9)
#define IN(k) (((PHMASK >> PHT(k)) & 1) && lo <= (k) && (k) < hi)
#define SEAM(k) do { if (IN(k) && IN((k) + 1)) { KSEG_FENCE(); XcdBarrier _b; _b.bar = ctl + CW_BAR; _b.x = my_xcc; _b.st = MISC; xcd_barrier(_b); } KSEG_FENCE(); } while (0)

    if (IN(0)) {
        const int l0 = 0; PHASE_BEGIN();
        {
            LAS float* cact = (LAS float*)lds;
            LAS float* part = (LAS float*)(lds + 8192);
            for (int i = tid; i < 2 * D; i += NWAVES * 64) cact[i] = silu_f(KIN(I_C)[i]);
            __syncthreads();
            const int jj = tid & 63, ks = tid >> 6;
            for (int item = bid; item < DEPTH * 96; item += G) {
                const int l = item / 96, j0 = (item % 96) * 64;
                const float* w = KIN(I_ADAW) + (size_t)l * D * 6144 + (size_t)(ks * 128) * 6144 + j0 + jj;
                float a0 = 0.f, a1 = 0.f;
#pragma unroll 8
                for (int k = 0; k < 128; ++k) { const float wv = w[(size_t)k * 6144]; a0 += cact[ks * 128 + k] * wv; a1 += cact[D + ks * 128 + k] * wv; }
                part[(ks * 64 + jj) * 2 + 0] = a0; part[(ks * 64 + jj) * 2 + 1] = a1;
                __syncthreads();
                if (tid < 128) { const int j = tid & 63, b = tid >> 6; float s = KIN(I_ADAB)[l * 6144 + j0 + j];
#pragma unroll
                    for (int q = 0; q < 8; ++q) s += part[(q * 64 + j) * 2 + b];
                    MOD[(size_t)(l * 2 + b) * 6144 + j0 + j] = s; }
                __syncthreads();
            }
        }
        {
            for (int i = bid * (NWAVES * 64) + tid; i < DEPTH * 36 * D; i += G * NWAVES * 64) {
                const int l = i / (36 * D), r = i % (36 * D), e = r / D, k = r % D;
                WRT[i] = (e < 4) ? KIN(I_RGW)[((size_t)l * D + k) * 4 + e] : KIN(I_REW)[((size_t)l * D + k) * 32 + (e - 4)];
            }
        }
        {
            LAS float* scr = (LAS float*)(lds + wave * 16384);
            constexpr int NI_IN = 16 * 88, NI_OUT = 16 * 32, NI_GU = 32 * 2 * 16 * 8, NI_DN = 32 * 4 * 32, NL = NI_IN + NI_OUT + NI_GU + NI_DN;
            for (int it = gw; it < DEPTH * NL; it += NGW) {
                const int l = it / NL; int r = it % NL;
                const float* src; int lds_src; bf16_t* dst; int ld_dst; bool gk = false; int gk_n0 = 0, gk_k0 = 0;
                if (r < NI_IN) { const int kb = r / 88, db = r % 88, n0 = 32 * db;
                    dst = WIN + ((size_t)l * NP + n0) * D + 64 * kb; ld_dst = D; lds_src = INC;
                    if (db >= 16 && db < 24) { gk = true; gk_n0 = n0 - PG; gk_k0 = 64 * kb; src = KIN(I_WIN) + (size_t)l * D * INC; }
                    else { const int sc = n0 < 512 ? n0 : (n0 < PU ? n0 - 256 : n0 - 240); src = KIN(I_WIN) + (size_t)l * D * INC + (size_t)(64 * kb) * INC + sc; }
                } else if ((r -= NI_IN) < NI_OUT) { const int kb = r / 32, nb = r % 32;
                    src = KIN(I_WOUT) + (size_t)l * D * D + (size_t)(64 * kb) * D + 32 * nb; lds_src = D; dst = WOUT + ((size_t)l * D + 32 * nb) * D + 64 * kb; ld_dst = D;
                } else if ((r -= NI_OUT) < NI_GU) { const int e = r / 256, q = r % 256, which = q / 128, q2 = q % 128, kb = q2 / 8, nb = q2 % 8, f0 = 32 * nb;
                    const int drow = (f0 >> 7) * 256 + which * 128 + (f0 & 127);
                    src = KIN(which ? I_EWU : I_EWG) + ((size_t)(l * 32 + e) * D + 64 * kb) * 256 + f0; lds_src = 256;
                    dst = WGU + ((size_t)(l * 32 + e) * 512 + drow) * D + 64 * kb; ld_dst = D;
                } else { r -= NI_GU; const int e = r / 128, q = r % 128, kb = q / 32, nb = q % 32;
                    src = KIN(I_EWD) + ((size_t)(l * 32 + e) * 256 + 64 * kb) * D + 32 * nb; lds_src = D;
                    dst = WD + ((size_t)(l * 32 + e) * D + 32 * nb) * 256 + 64 * kb; ld_dst = 256;
                }
                if (gk) {
                    const float* wg2 = KIN(I_WG2) + (size_t)l * 16 * 256;
#pragma unroll 4
                    for (int i = 0; i < 32; ++i) { const int kk = 2 * i + (lane >> 5), nn = lane & 31; const float* wl = src + (size_t)(gk_k0 + kk) * INC + 1536; float s = 0.f;
#pragma unroll
                        for (int q = 0; q < 16; ++q) s += wl[q] * wg2[q * 256 + gk_n0 + nn];
                        scr[kk * 33 + nn] = s; }
                } else {
#pragma unroll 8
                    for (int i = 0; i < 32; ++i) { const int kk = 2 * i + (lane >> 5); scr[kk * 33 + (lane & 31)] = src[(size_t)kk * lds_src + (lane & 31)]; }
                }
                LDS_WAIT(); asm volatile("" ::: "memory");
                const int c = lane & 7;
#pragma unroll
                for (int j = 0; j < 4; ++j) { const int n = (lane >> 3) + 8 * j; const LAS float* s = scr + (8 * c) * 33 + n;
                    u32x4 o; o.x = cvt_pk_bf16(s[0 * 33], s[1 * 33]); o.y = cvt_pk_bf16(s[2 * 33], s[3 * 33]); o.z = cvt_pk_bf16(s[4 * 33], s[5 * 33]); o.w = cvt_pk_bf16(s[6 * 33], s[7 * 33]);
                    *(u32x4*)(dst + (size_t)n * ld_dst + 8 * c) = o; }
                LDS_WAIT(); asm volatile("" ::: "memory");
            }
        }
    }
    SEAM(0);

#define NORM_ROW(xrow, hrow, gp, scp, shp) do { \
        f32x4 _v[4]; float _s = 0.f; \
        _Pragma("unroll") for (int _j = 0; _j < 4; ++_j) { _v[_j] = *((const f32x4*)(xrow) + lane + 64 * _j); _s += (_v[_j].x * _v[_j].x + _v[_j].y * _v[_j].y) + (_v[_j].z * _v[_j].z + _v[_j].w * _v[_j].w); } \
        const float _r = __builtin_amdgcn_rsqf(wave_sum(_s) * (1.f / D) + EPS); \
        _Pragma("unroll") for (int _j = 0; _j < 4; ++_j) { const f32x4 _g = *((const f32x4*)(gp) + lane + 64 * _j), _sc = *((const f32x4*)(scp) + lane + 64 * _j), _sh = *((const f32x4*)(shp) + lane + 64 * _j); \
            const f32x4 _h = (_v[_j] * _r) * _g * (_sc + 1.f) + _sh; u32x2 _o; _o.x = cvt_pk_bf16(_h.x, _h.y); _o.y = cvt_pk_bf16(_h.z, _h.w); *((u32x2*)(hrow) + lane + 64 * _j) = _o; } } while (0)

    if (IN(1)) {
        const int l0 = 0; PHASE_BEGIN();
        for (int m = gw; m < T; m += NGW) { const float* md = MOD + (size_t)(m >= SEQ ? 1 : 0) * 6144;
            NORM_ROW(KIN(I_X) + (size_t)m * D, H + (size_t)m * D, KIN(I_N1G), md + 1024, md); }
    }
    SEAM(1);

    for (int l0 = 0; l0 < DEPTH; ++l0) {
        const int pb = 2 + 9 * l0;
        if (IN(pb + 0)) {
            PHASE_BEGIN();
            pg8::DenseSched S; S.init(H, WIN + (size_t)l * NP * D, T, NP, G, bid);
            EpiInProj E{P, KIN(I_BG) + l * 256};
            pg8::gemm_phase<EpiInProj, pg8::DenseSched>(lds, tid, D, S, E);
        }
        SEAM(pb + 0);

        if (IN(pb + 1)) {
            PHASE_BEGIN();
            {
                LAS float* ke = (LAS float*)lds;
                LAS float* vv = (LAS float*)(lds + 16384);
                LAS float* segtot = (LAS float*)(lds + 49152);
                const int col = tid & 63, seg = tid >> 6;
                for (int unit = bid; unit < NCH * 4; unit += G) {
                    const int cn = unit >> 2, h = unit & 3;
                    const bf16_t* Pc = P + (size_t)(cn * 64) * NP;
                    float g[8], kk[8]; float run = 0.f;
#pragma unroll
                    for (int i = 0; i < 8; ++i) { const size_t ro = (size_t)(seg * 8 + i) * NP; run += bf2f(Pc[ro + PG + h * 64 + col]); g[i] = run; kk[i] = bf2f(Pc[ro + PK + h * 64 + col]); }
                    segtot[seg * 64 + col] = run;
#pragma unroll
                    for (int i = 0; i < 16; ++i) { const int idx = tid + 512 * i, p = idx >> 7, vd = idx & 127; vv[p * 128 + vd] = bf2f(Pc[(size_t)p * NP + PV + h * 128 + vd]); }
                    __syncthreads();
                    float offs = 0.f, blast = 0.f;
#pragma unroll
                    for (int s = 0; s < 8; ++s) { const float tv = segtot[s * 64 + col]; if (s < seg) offs += tv; blast += tv; }
#pragma unroll
                    for (int i = 0; i < 8; ++i) ke[(seg * 8 + i) * 64 + col] = kk[i] * __expf(blast - (offs + g[i]));
                    if (seg == 0) DECAY[(size_t)(cn * 4 + h) * 64 + col] = __expf(blast);
                    __syncthreads();
                    {
                        const int vd = tid & 127, kd0 = (tid >> 7) * 16; float a[16];
#pragma unroll
                        for (int q = 0; q < 16; ++q) a[q] = 0.f;
                        for (int j = 0; j < 64; ++j) { const float x = vv[j * 128 + vd];
#pragma unroll
                            for (int q = 0; q < 16; ++q) a[q] += ke[j * 64 + kd0 + q] * x; }
                        float* o = KVT + ((size_t)(cn * 4 + h) * 128 + vd) * 64 + kd0;
#pragma unroll
                        for (int q = 0; q < 4; ++q) *(f32x4*)(o + 4 * q) = (f32x4){a[4 * q], a[4 * q + 1], a[4 * q + 2], a[4 * q + 3]};
                    }
                    __syncthreads();
                }
            }
            {
                LAS float* vn = (LAS float*)lds;
                const float* lng = KIN(I_LNG) + l * 512; const float* lnb = KIN(I_LNB) + l * 512;
                for (int unit = bid; unit < 2 * 64 * 4; unit += G) {
                    const int g = unit & 3, blk = (unit >> 2) & 63, b = unit >> 8;
                    const int t0 = b * SEQ + blk * 128;
                    const int row = tid >> 2, part = tid & 3;
                    const bf16_t* pr = P + (size_t)(t0 + row) * NP + PSV;
                    float s = 0.f, s2 = 0.f;
                    for (int c = 0; c < 128; c += 8) { const u32x4 w = *(const u32x4*)(pr + part * 128 + c);
#pragma unroll
                        for (int q = 0; q < 4; ++q) { const float x0 = __builtin_bit_cast(float, w[q] << 16), x1 = __builtin_bit_cast(float, w[q] & 0xffff0000u); s += x0 + x1; s2 += x0 * x0 + x1 * x1; } }
                    s += __shfl_xor(s, 1); s += __shfl_xor(s, 2); s2 += __shfl_xor(s2, 1); s2 += __shfl_xor(s2, 2);
                    const float mean = s * (1.f / 512.f); const float var = fmaxf(s2 * (1.f / 512.f) - mean * mean, 0.f); const float rstd = __builtin_amdgcn_rsqf(var + EPS);
                    for (int c = 0; c < 32; ++c) { const int cc = part * 32 + c; vn[row * 128 + cc] = (bf2f(pr[g * 128 + cc]) - mean) * rstd * lng[g * 128 + cc] + lnb[g * 128 + cc]; }
                    __syncthreads();
                    {
                        const int i = tid >> 2, c0 = (tid & 3) * 32; float a[32];
#pragma unroll
                        for (int q = 0; q < 32; ++q) a[q] = 0.f;
                        const float* wrow = KIN(I_SWS) + ((size_t)(l * 4 + g) * 128 + i) * 128;
                        const int jlim = (i < 64) ? 64 : 128;
                        for (int j = 0; j < jlim; ++j) { const float w = wrow[j];
#pragma unroll
                            for (int q = 0; q < 32; ++q) a[q] += w * vn[j * 128 + c0 + q]; }
                        const float bs = KIN(I_SBS)[(l * 4 + g) * 128 + i];
                        const bf16_t* ur = P + (size_t)(t0 + i) * NP + PU + g * 128 + c0;
                        float ss = 0.f;
#pragma unroll
                        for (int q = 0; q < 32; ++q) { a[q] = bf2f(ur[q]) * (a[q] + bs); ss += a[q] * a[q]; }
                        ss += __shfl_xor(ss, 1); ss += __shfl_xor(ss, 2);
                        const float r = __builtin_amdgcn_rsqf(ss * (1.f / 128.f) + EPS);
                        const float* og = KIN(I_SONG) + (l * 4 + g) * 128 + c0;
                        bf16_t* orow = OMIX + (size_t)(t0 + i) * D + 512 + g * 128 + c0;
#pragma unroll
                        for (int q = 0; q < 32; q += 2) *(unsigned*)(orow + q) = cvt_pk_bf16(a[q] * r * og[q], a[q + 1] * r * og[q + 1]);
                    }
                    __syncthreads();
                }
            }
        }
        SEAM(pb + 1);

        if (IN(pb + 2)) {
            PHASE_BEGIN();
            if (tid < 256) {
                for (int ei = bid * 256 + tid; ei < 65536; ei += G * 256) {
                    const int bh = ei >> 13, rem = ei & 8191, vd = rem >> 6, kd = rem & 63, b = bh >> 2, h = bh & 3;
                    float Sv = 0.f;
                    for (int n = 0; n < 128; n += 8) {
                        float dc[8], kv[8];
#pragma unroll
                        for (int q = 0; q < 8; ++q) { const int cn = b * 128 + n + q; dc[q] = DECAY[(size_t)(cn * 4 + h) * 64 + kd]; kv[q] = KVT[((size_t)(cn * 4 + h) * 128 + vd) * 64 + kd]; }
#pragma unroll
                        for (int q = 0; q < 8; ++q) { const int cn = b * 128 + n + q; ST[((size_t)(cn * 4 + h) * 128 + vd) * 64 + kd] = f2bf(Sv); Sv = dc[q] * Sv + kv[q]; }
                    }
                }
            }
        }
        SEAM(pb + 2);

        if (IN(pb + 3)) {
            PHASE_BEGIN();
            LAS float* qd = (LAS float*)lds;
            LAS float* ki = (LAS float*)(lds + 16640);
            LAS float* vv = (LAS float*)(lds + 33280);
            LAS float* att = (LAS float*)(lds + 66048);
            LAS float* Sm = (LAS float*)(lds + 82688);
            LAS float* segtot = (LAS float*)(lds + 115456);
            const int col = tid & 63, seg = tid >> 6;
            const float* ong = KIN(I_GONG) + l * 128;
            for (int unit = bid; unit < NCH * 4; unit += G) {
                const int cn = unit >> 2, h = unit & 3;
                const bf16_t* Pc = P + (size_t)(cn * 64) * NP;
                float g[8], kk[8], qq[8]; float run = 0.f;
#pragma unroll
                for (int i = 0; i < 8; ++i) { const size_t ro = (size_t)(seg * 8 + i) * NP; run += bf2f(Pc[ro + PG + h * 64 + col]); g[i] = run; kk[i] = bf2f(Pc[ro + PK + h * 64 + col]); qq[i] = bf2f(Pc[ro + PQ + h * 64 + col]); }
                segtot[seg * 64 + col] = run;
#pragma unroll
                for (int i = 0; i < 16; ++i) { const int idx = tid + 512 * i, p = idx >> 7, vd = idx & 127; vv[p * 128 + vd] = bf2f(Pc[(size_t)p * NP + PV + h * 128 + vd]); }
#pragma unroll
                for (int i = 0; i < 16; ++i) { const int idx = tid + 512 * i, vd = idx >> 6, kd = idx & 63; Sm[kd * 128 + vd] = bf2f(ST[((size_t)(cn * 4 + h) * 128 + vd) * 64 + kd]); }
                __syncthreads();
                float offs = 0.f;
#pragma unroll
                for (int s = 0; s < 8; ++s) { const float tv = segtot[s * 64 + col]; if (s < seg) offs += tv; }
#pragma unroll
                for (int i = 0; i < 8; ++i) { const float bb = offs + g[i]; qd[(seg * 8 + i) * 65 + col] = qq[i] * __expf(bb); ki[(seg * 8 + i) * 65 + col] = kk[i] * __expf(-bb); }
                __syncthreads();
                {
                    const int i = tid >> 3, j0 = (tid & 7) * 8; float a[8];
#pragma unroll
                    for (int q = 0; q < 8; ++q) a[q] = 0.f;
                    for (int kd = 0; kd < 64; ++kd) { const float x = qd[i * 65 + kd];
#pragma unroll
                        for (int q = 0; q < 8; ++q) a[q] += x * ki[(j0 + q) * 65 + kd]; }
#pragma unroll
                    for (int q = 0; q < 8; ++q) att[i * 65 + j0 + q] = (j0 + q <= i) ? a[q] : 0.f;
                }
                __syncthreads();
                {
                    const int i = tid >> 3, v0 = (tid & 7) * 16; float a[16];
#pragma unroll
                    for (int q = 0; q < 16; ++q) a[q] = 0.f;
                    for (int j = 0; j <= i; ++j) { const float x = att[i * 65 + j];
#pragma unroll
                        for (int q = 0; q < 16; ++q) a[q] += x * vv[j * 128 + v0 + q]; }
                    for (int kd = 0; kd < 64; ++kd) { const float x = qd[i * 65 + kd];
#pragma unroll
                        for (int q = 0; q < 16; ++q) a[q] += x * Sm[kd * 128 + v0 + q]; }
                    float ss = 0.f;
#pragma unroll
                    for (int q = 0; q < 16; ++q) ss += a[q] * a[q];
                    ss += __shfl_xor(ss, 1); ss += __shfl_xor(ss, 2); ss += __shfl_xor(ss, 4);
                    const float r = __builtin_amdgcn_rsqf(ss * (1.f / 128.f) + EPS);
                    const int t = cn * 64 + i;
                    const bf16_t* ogr = P + (size_t)t * NP + POG + h * 128 + v0;
                    bf16_t* orow = OMIX + (size_t)t * D + h * 128 + v0;
#pragma unroll
                    for (int q = 0; q < 16; q += 2) *(unsigned*)(orow + q) = cvt_pk_bf16(a[q] * r * ong[v0 + q] * bf2f(ogr[q]), a[q + 1] * r * ong[v0 + q + 1] * bf2f(ogr[q + 1]));
                }
                __syncthreads();
            }
        }
        SEAM(pb + 3);

        if (IN(pb + 4)) {
            PHASE_BEGIN();
            pg8::DenseSched S; S.init(OMIX, WOUT + (size_t)l * D * D, T, D, G, bid);
            EpiOutProj E{l == 0 ? KIN(I_X) : XOUT, XOUT, modl + 2048};
            pg8::gemm_phase<EpiOutProj, pg8::DenseSched>(lds, tid, D, S, E);
        }
        SEAM(pb + 4);

        if (IN(pb + 5)) {
            PHASE_BEGIN();
            const float* wrt = WRT + (size_t)l * 36 * D;
            unsigned* cntg = ctl + CW_CNT + l * 64;
            for (int t8 = gw * 8; t8 < T; t8 += NGW * 8) {
                const float* md = modl + (size_t)(t8 >= SEQ ? 1 : 0) * 6144;
                f32x4 cs[4], sh[4];
#pragma unroll
                for (int j = 0; j < 4; ++j) { const f32x4 gg = *((const f32x4*)(KIN(I_N2G) + l * D) + lane + 64 * j), sc = *((const f32x4*)(md + 4096) + lane + 64 * j); cs[j] = gg * (sc + 1.f); sh[j] = *((const f32x4*)(md + 3072) + lane + 64 * j); }
                f32x4 hv[8][4];
#pragma unroll
                for (int tk = 0; tk < 8; ++tk) {
                    const float* xr = XOUT + (size_t)(t8 + tk) * D; float s = 0.f;
#pragma unroll
                    for (int j = 0; j < 4; ++j) { hv[tk][j] = *((const f32x4*)xr + lane + 64 * j); s += (hv[tk][j].x * hv[tk][j].x + hv[tk][j].y * hv[tk][j].y) + (hv[tk][j].z * hv[tk][j].z + hv[tk][j].w * hv[tk][j].w); }
                    const float r = __builtin_amdgcn_rsqf(wave_sum(s) * (1.f / D) + EPS);
#pragma unroll
                    for (int j = 0; j < 4; ++j) { hv[tk][j] = (hv[tk][j] * r) * cs[j] + sh[j]; u32x2 o; o.x = cvt_pk_bf16(hv[tk][j].x, hv[tk][j].y); o.y = cvt_pk_bf16(hv[tk][j].z, hv[tk][j].w);
                        *((u32x2*)(H + (size_t)(t8 + tk) * D) + lane + 64 * j) = o; }
                }
                float lg[8];
#pragma unroll
                for (int tk = 0; tk < 8; ++tk) lg[tk] = 0.f;
                for (int e = 0; e < 36; ++e) {
                    f32x4 w[4];
#pragma unroll
                    for (int j = 0; j < 4; ++j) w[j] = *((const f32x4*)(wrt + (size_t)e * D) + lane + 64 * j);
#pragma unroll
                    for (int tk = 0; tk < 8; ++tk) { float d = 0.f;
#pragma unroll
                        for (int j = 0; j < 4; ++j) d += (hv[tk][j].x * w[j].x + hv[tk][j].y * w[j].y) + (hv[tk][j].z * w[j].z + hv[tk][j].w * w[j].w);
                        d = wave_sum(d); if (lane == e) lg[tk] = d; }
                }
                const float bias = (lane < 4) ? KIN(I_RGB)[l * 4 + lane] : ((lane < 36) ? KIN(I_REB)[l * 32 + lane - 4] : 0.f);
#pragma unroll
                for (int tk = 0; tk < 8; ++tk) {
                    const float v = lg[tk] + bias;
                    float gl[4];
#pragma unroll
                    for (int q = 0; q < 4; ++q) gl[q] = __shfl(v, q);
                    int gi = 0; float gm = gl[0];
#pragma unroll
                    for (int q = 1; q < 4; ++q) if (gl[q] > gm) { gm = gl[q]; gi = q; }
                    float den = 0.f;
#pragma unroll
                    for (int q = 0; q < 4; ++q) den += __expf(gl[q] - gm);
                    const float gwt = 1.f / den;
                    float el[8];
#pragma unroll
                    for (int q = 0; q < 8; ++q) el[q] = __shfl(v, 4 + gi * 8 + q);
                    int i1 = 0; float v1 = el[0];
#pragma unroll
                    for (int q = 1; q < 8; ++q) if (el[q] > v1) { v1 = el[q]; i1 = q; }
                    int i2 = -1; float v2 = -3.0e38f;
#pragma unroll
                    for (int q = 0; q < 8; ++q) if (q != i1 && el[q] > v2) { v2 = el[q]; i2 = q; }
                    const float ex = __expf(v2 - v1); const float w1 = gwt / (1.f + ex), w2 = gwt * ex / (1.f + ex);
                    if (lane == 0) {
                        const int t = t8 + tk, e1 = gi * 8 + i1, e2 = gi * 8 + i2;
                        const int s1 = (int)atomicAdd(cntg + e1, 1u), s2 = (int)atomicAdd(cntg + e2, 1u);
                        TOK[(size_t)e1 * T + s1] = t; WL[(size_t)e1 * T + s1] = w1; TOK[(size_t)e2 * T + s2] = t; WL[(size_t)e2 * T + s2] = w2;
                        REF[2 * t] = (e1 << 16) | s1; REF[2 * t + 1] = (e2 << 16) | s2;
                    }
                }
            }
        }
        SEAM(pb + 5);

#define MOE_TABLES(NSUB) do { __syncthreads(); if (tid < 32) TB_CNT[tid] = (int)__hip_atomic_load(ctl + CW_CNT + l * 64 + tid, __ATOMIC_RELAXED, __HIP_MEMORY_SCOPE_AGENT); __syncthreads(); \
        if (tid == 0) { int _tp = 0, _bs = 0; for (int _e = 0; _e < 32; ++_e) { TB_TP[_e] = _tp; TB_BASE[_e] = _bs; _tp += (TB_CNT[_e] + 255) >> 8; _bs += TB_CNT[_e]; } TB_TP[32] = _tp; TB_BASE[32] = _bs; } __syncthreads(); \
        if (tid < 16) { const int _L = tid * G + bid, _tile = _L / (NSUB); int _e = -1; if (_tile < TB_TP[32]) { _e = 0; for (int _j = 1; _j < 32; ++_j) _e += (TB_TP[_j] <= _tile) ? 1 : 0; } TB_UE[tid] = _e; } __syncthreads(); } while (0)

        if (IN(pb + 6)) {
            PHASE_BEGIN();
            MOE_TABLES(2);
            MoeSched1 S{{TB_TP, TB_CNT, TB_BASE, TB_UE}, (const char*)H, (const char*)(WGU + (size_t)l * 32 * 512 * D), TOK, G, bid};
            EpiMoe1 E{ACT, WL};
            pg8::gemm_phase<EpiMoe1, MoeSched1>(lds, tid, D, S, E);
        }
        SEAM(pb + 6);

        if (IN(pb + 7)) {
            PHASE_BEGIN();
            MOE_TABLES(4);
            MoeSched2 S{{TB_TP, TB_CNT, TB_BASE, TB_UE}, (const char*)ACT, (const char*)(WD + (size_t)l * 32 * D * 256), nullptr, G, bid};
            EpiMoe2 E{Y};
            pg8::gemm_phase<EpiMoe2, MoeSched2>(lds, tid, 256, S, E);
        }
        SEAM(pb + 7);

        if (IN(pb + 8)) {
            PHASE_BEGIN();
            MOE_TABLES(1);
            for (int t = gw; t < T; t += NGW) {
                const int b = t >= SEQ ? 1 : 0;
                const int r1 = REF[2 * t], r2 = REF[2 * t + 1];
                const bf16_t* y1 = Y + (size_t)(TB_BASE[r1 >> 16] + (r1 & 0xffff)) * D; const bf16_t* y2 = Y + (size_t)(TB_BASE[r2 >> 16] + (r2 & 0xffff)) * D;
                const float* gt = modl + (size_t)b * 6144 + 5120;
                float* xr = XOUT + (size_t)t * D;
                f32x4 v[4]; float s = 0.f;
#pragma unroll
                for (int j = 0; j < 4; ++j) {
                    const f32x4 xo = *((const f32x4*)xr + lane + 64 * j), gg = *((const f32x4*)gt + lane + 64 * j);
                    const u32x2 a = *((const u32x2*)y1 + lane + 64 * j), c = *((const u32x2*)y2 + lane + 64 * j);
                    f32x4 m; m.x = __builtin_bit_cast(float, a.x << 16) + __builtin_bit_cast(float, c.x << 16); m.y = __builtin_bit_cast(float, a.x & 0xffff0000u) + __builtin_bit_cast(float, c.x & 0xffff0000u);
                    m.z = __builtin_bit_cast(float, a.y << 16) + __builtin_bit_cast(float, c.y << 16); m.w = __builtin_bit_cast(float, a.y & 0xffff0000u) + __builtin_bit_cast(float, c.y & 0xffff0000u);
                    v[j] = xo + gg * m; s += (v[j].x * v[j].x + v[j].y * v[j].y) + (v[j].z * v[j].z + v[j].w * v[j].w);
                }
                const float r = __builtin_amdgcn_rsqf(wave_sum(s) * (1.f / D) + EPS);
                if (l + 1 < DEPTH) {
                    const float* md = MOD + (size_t)((l + 1) * 2 + b) * 6144; const float* gp = KIN(I_N1G) + (l + 1) * D;
#pragma unroll
                    for (int j = 0; j < 4; ++j) { *((f32x4*)xr + lane + 64 * j) = v[j];
                        const f32x4 g = *((const f32x4*)gp + lane + 64 * j), sc = *((const f32x4*)(md + 1024) + lane + 64 * j), sh = *((const f32x4*)md + lane + 64 * j);
                        const f32x4 hh = (v[j] * r) * g * (sc + 1.f) + sh; u32x2 o; o.x = cvt_pk_bf16(hh.x, hh.y); o.y = cvt_pk_bf16(hh.z, hh.w); *((u32x2*)(H + (size_t)t * D) + lane + 64 * j) = o; }
                } else {
#pragma unroll
                    for (int j = 0; j < 4; ++j) { const f32x4 g = *((const f32x4*)KIN(I_FING) + lane + 64 * j); *((f32x4*)xr + lane + 64 * j) = (v[j] * r) * g; }
                }
            }
        }
        SEAM(pb + 8);
    }
#undef IN
#undef SEAM
}

extern "C" void kernel_launch(void* const* d_in, const int* in_sizes, int n_in, void* d_out, int out_size, void* d_ws, size_t ws_size, hipStream_t stream) {
    static int grid = 0;
    if (grid == 0) {
        if (n_in != 24 || out_size != T * D || ws_size < WS_END) { fprintf(stderr, "kernel_launch: unexpected shapes (n_in %d, out %d, ws %zu)\n", n_in, out_size, ws_size); grid = -1; return; }
        int dev = 0, cus = 0, per_cu = 0;
        if (hipGetDevice(&dev) != hipSuccess || hipDeviceGetAttribute(&cus, hipDeviceAttributeMultiprocessorCount, dev) != hipSuccess) { grid = -1; return; }
        if (hipFuncSetAttribute((const void*)fwd_kernel, hipFuncAttributeMaxDynamicSharedMemorySize, LDS_BYTES) != hipSuccess) { fprintf(stderr, "kernel_launch: hipFuncSetAttribute failed\n"); grid = -1; return; }
        if (hipOccupancyMaxActiveBlocksPerMultiprocessor(&per_cu, (const void*)fwd_kernel, NWAVES * 64, LDS_BYTES) != hipSuccess || per_cu < 1) { fprintf(stderr, "kernel_launch: occupancy query says %d\n", per_cu); }
        (void)hipGetLastError();
        grid = cus;
    }
    if (grid < 0) return;
    if (hipMemsetAsync((char*)d_ws + WS_CTL, 0, CTL_ZERO_BYTES, stream) != hipSuccess) return;
    Args a{};
    for (int i = 0; i < 24; ++i) a.in[i] = (const float*)d_in[i];
    a.out = (float*)d_out; a.ws = (unsigned char*)d_ws;
#if MK_SPLIT
    for (int p = 0; p < NPH; ++p) { a.ph_lo = p; a.ph_hi = p + 1; hipLaunchKernelGGL(fwd_kernel, dim3(grid), dim3(NWAVES * 64), LDS_BYTES, stream, a); }
#else
    a.ph_lo = 0; a.ph_hi = NPH;
    hipLaunchKernelGGL(fwd_kernel, dim3(grid), dim3(NWAVES * 64), LDS_BYTES, stream, a);
#endif
}
```

```cpp
#include <hip/hip_runtime.h>
#include <cstdio>
#include <cstdint>

#ifndef MK_SPLIT
#define MK_SPLIT 0
#endif
#ifndef MFMA_SGU
#define MFMA_SGU 1
#endif
#ifndef MFMA_G1
#define MFMA_G1 1
#endif
#ifndef MFMA_G2
#define MFMA_G2 1
#endif

#define LAS __attribute__((address_space(3)))
#define CAS __attribute__((address_space(4)))
#define GAS __attribute__((address_space(1)))
typedef unsigned short bf16_t;
typedef short bf16x8 __attribute__((ext_vector_type(8)));
typedef float f32x4 __attribute__((ext_vector_type(4)));
typedef float f32x2 __attribute__((ext_vector_type(2)));
typedef unsigned u32x4 __attribute__((ext_vector_type(4)));
typedef unsigned u32x2 __attribute__((ext_vector_type(2)));

constexpr int D = 1024, SEQ = 8192, T = 16384, DEPTH = 4, NWAVES = 8;
constexpr int INC = 2576;
constexpr int NP = 2816;
constexpr int PQ = 0, PK = 256, PG = 512, PV = 768, POG = 1280, PU = 1792, PSV = 2304;
constexpr int NCH = 256;
constexpr float EPS = 1e-6f;
constexpr int NPH = 2 + 9 * DEPTH;

constexpr size_t MiB = 1u << 20;
constexpr size_t WS_CTL = 0, CTL_ZERO_BYTES = 1 * MiB;
constexpr size_t WS_MOD = 1 * MiB;
constexpr size_t WS_WRH = 2 * MiB;
constexpr size_t WS_WRL = 2 * MiB + 512 * 1024;
constexpr size_t WS_SHW = 1 * MiB + 256 * 1024;
constexpr size_t WS_TOK = 3 * MiB;
constexpr size_t WS_WL = 5 * MiB;
constexpr size_t WS_REF = 7 * MiB;
constexpr size_t WS_DECAY = 8 * MiB;
constexpr size_t WS_WIN = 10 * MiB;
constexpr size_t WS_WOUT = 32 * MiB;
constexpr size_t WS_WGU = 40 * MiB;
constexpr size_t WS_WD = 168 * MiB;
constexpr size_t WS_H = 232 * MiB;
constexpr size_t WS_P = 264 * MiB;
constexpr size_t WS_Y = 264 * MiB;
constexpr size_t WS_KVT = 352 * MiB;
constexpr size_t WS_ACT = 352 * MiB;
constexpr size_t WS_ST = 384 * MiB;
constexpr size_t WS_OMIX = 400 * MiB;
constexpr size_t WS_VT = 432 * MiB;
constexpr size_t WS_END = 448 * MiB;
constexpr size_t WS_DRY = 448 * MiB;
constexpr int CW_BAR = 4096;
constexpr int CW_CNT = 16384;

constexpr int RING_BYTES = 131072;
constexpr int MISC_OFF = RING_BYTES;
constexpr int LDS_BYTES = 147456;

__device__ __forceinline__ float bf2f(bf16_t v) { return __builtin_bit_cast(float, (unsigned)v << 16); }
typedef __bf16 bf16x2_t __attribute__((ext_vector_type(2)));
__device__ __forceinline__ unsigned cvt_pk_bf16(float lo, float hi) { const f32x2 v = {lo, hi}; const bf16x2_t b = __builtin_convertvector(v, bf16x2_t); return __builtin_bit_cast(unsigned, b); }
typedef short s16x4 __attribute__((ext_vector_type(4)));
typedef short v4i16_t __attribute__((ext_vector_type(4)));
typedef float f32x16 __attribute__((ext_vector_type(16)));
__device__ __forceinline__ s16x4 lds_tr(const LAS unsigned char* p) { return __builtin_bit_cast(s16x4, __builtin_amdgcn_ds_read_tr16_b64_v4i16((LAS v4i16_t*)p)); }
#define MFMA32(a, b, c) __builtin_amdgcn_mfma_f32_32x32x16_bf16((a), (b), (c), 0, 0, 0)
__device__ __forceinline__ bf16x8 cat4(s16x4 lo, s16x4 hi) { return __builtin_shufflevector(lo, hi, 0, 1, 2, 3, 4, 5, 6, 7); }
__device__ __forceinline__ bf16x8 pack8(float a0, float a1, float a2, float a3, float a4, float a5, float a6, float a7) {
    u32x4 w; w.x = cvt_pk_bf16(a0, a1); w.y = cvt_pk_bf16(a2, a3); w.z = cvt_pk_bf16(a4, a5); w.w = cvt_pk_bf16(a6, a7); return __builtin_bit_cast(bf16x8, w); }
__device__ __forceinline__ float bflo(unsigned w) { return __builtin_bit_cast(float, w << 16); }
__device__ __forceinline__ float bfhi(unsigned w) { return __builtin_bit_cast(float, w & 0xffff0000u); }
__device__ __forceinline__ bf16_t f2bf(float f) { return (bf16_t)(cvt_pk_bf16(f, 0.f) & 0xffffu); }
__device__ __forceinline__ float wave_sum(float v) {
#pragma unroll
    for (int o = 1; o < 64; o <<= 1) v += __shfl_xor(v, o);
    return v;
}
__device__ __forceinline__ float silu_f(float x) { return x * __builtin_amdgcn_rcpf(1.f + __expf(-x)); }
__device__ __forceinline__ float gelu_tanh_f(float x) { const float u = 0.7978845608028654f * (x + 0.044715f * x * x * x); return x * __builtin_amdgcn_rcpf(1.f + __expf(-2.f * u)); }
__device__ __forceinline__ float logsig_f(float z) { return fminf(z, 0.f) - __logf(1.f + __expf(-fabsf(z))); }
#define LDS_WAIT() asm volatile("s_waitcnt lgkmcnt(0)" ::: "memory")
__device__ __forceinline__ const char* uni_ptr(const char* p) {
    unsigned long long v = (unsigned long long)p; unsigned lo = __builtin_amdgcn_readfirstlane((unsigned)v), hi = __builtin_amdgcn_readfirstlane((unsigned)(v >> 32));
    return (const char*)(((unsigned long long)hi << 32) | lo);
}

namespace pg8 {
constexpr int BM = 256, BK = 64, HALF = 128, HTB = HALF * BK * 2, STAGE_BYTES = 8 * HTB, NXCD = 8, WGM = 8;
__host__ __device__ __forceinline__ int lds_byte(int r, int c) { const int st = (r >> 4) * 2 + (c >> 5), rr = r & 15, cc = c & 31, ob = rr * 64 + cc * 2; return st * 1024 + (ob ^ (((ob >> 9) & 1) << 5)); }
__host__ __device__ __forceinline__ void stage_rc(int b, int& R, int& C) { const int st = b / 1024, sb = b % 1024, swz = sb ^ (((sb >> 9) & 1) << 5); R = (st >> 1) * 16 + swz / 64; C = (st & 1) * 32 + (swz % 64) / 2; }
__host__ __device__ __forceinline__ int perm32(int rho) { const int n = rho >> 4, i = rho & 15; return 8 * (i >> 2) + 4 * n + (i & 3); }

struct Unit { int arow, brow, row0, col0, nvalid, toff; };

struct DenseSched {
    static constexpr bool GATHER = false;
    const char* A; const char* B; const int* tok; int nM, nN, nwg, G, c;
    __device__ void init(const void* A_, const void* Bt_, int M, int N, int G_, int c_) { A = (const char*)A_; B = (const char*)Bt_; tok = nullptr; nM = M / BM; nN = N / BM; nwg = nM * nN; G = G_; c = c_; }
    __device__ __forceinline__ bool next(int i, Unit& u) const {
        const long L = (long)i * G + c; if (L >= nwg) return false;
        int wgid = (int)L; { const int q = nwg / NXCD, r = nwg % NXCD, xcd = wgid % NXCD, off = wgid / NXCD; wgid = (xcd < r ? xcd * (q + 1) : r * (q + 1) + (xcd - r) * q) + off; }
        const int nig = WGM * nN, gid = wgid / nig, fm = gid * WGM, gsz = (nM - fm) < WGM ? (nM - fm) : WGM;
        const int pm = fm + ((wgid % nig) % gsz), pn = (wgid % nig) / gsz;
        u.arow = pm * BM; u.brow = pn * BM; u.row0 = pm * BM; u.col0 = pn * BM; u.nvalid = BM; u.toff = 0; return true;
    }
};

template <class Epi, class Sched>
__device__ __forceinline__ void gemm_phase(LAS unsigned char* lds, const int tid, const int K, const Sched& S, const Epi& E) {
    const int wid = __builtin_amdgcn_readfirstlane(tid >> 6), lane = tid & 63, wr = wid >> 2, wc = wid & 3, fr = lane & 15, fq = lane >> 4;
    const int nt = K / BK;
    int stR[2], stC[2]; unsigned voffB[2];
#pragma unroll
    for (int i = 0; i < 2; ++i) { int R, C; stage_rc(tid * 16 + i * 8192, R, C); stR[i] = R; stC[i] = C; const int Rb = Epi::PERM ? ((R & ~31) + perm32(R & 31)) : R; voffB[i] = (unsigned)(Rb * K + C) * 2u; }
    const size_t kstep = (size_t)(BK * 2);
    const size_t hstep = (size_t)HALF * K * 2;
    const unsigned ldsw = (unsigned)wid * 1024u;
    const int aoff = lds_byte(wr * 64 + fr, fq * 8), boff = lds_byte(wc * 32 + fr, fq * 8);
#define PG8_SA(b, h) (((b) * 2 + (h)) * HTB)
#define PG8_SB(b, h) ((4 + (b) * 2 + (h)) * HTB)
#define PG8_STAGE(bufoff, gbase, voff) do { _Pragma("unroll") for (int _i = 0; _i < 2; ++_i) \
        __builtin_amdgcn_global_load_lds((const unsigned*)((const char*)(gbase) + (voff)[_i]), (LAS unsigned*)(lds + (bufoff) + ldsw + _i * 8192), 16, 0, 0); } while (0)
#define PG8_LDA(dst, b, h) do { _Pragma("unroll") for (int m = 0; m < 4; ++m) _Pragma("unroll") for (int k = 0; k < 2; ++k) dst[m][k] = *(const LAS bf16x8*)(lds + PG8_SA(b, h) + aoff + m * 2048 + k * 1024); } while (0)
#define PG8_LDB(dst, b, h) do { _Pragma("unroll") for (int n = 0; n < 2; ++n) _Pragma("unroll") for (int k = 0; k < 2; ++k) dst[n][k] = *(const LAS bf16x8*)(lds + PG8_SB(b, h) + boff + n * 2048 + k * 1024); } while (0)
#define PG8_MMA(ai, bj, At, Bt) do { __builtin_amdgcn_s_setprio(1); _Pragma("unroll") for (int m = 0; m < 4; ++m) _Pragma("unroll") for (int n = 0; n < 2; ++n) _Pragma("unroll") for (int k = 0; k < 2; ++k) \
        acc[ai][bj][m][n] = __builtin_amdgcn_mfma_f32_16x16x32_bf16(Bt[n][k], At[m][k], acc[ai][bj][m][n], 0, 0, 0); __builtin_amdgcn_s_setprio(0); } while (0)
#define PG8_WAIT_V(n) asm volatile("s_waitcnt vmcnt(" #n ")" ::: "memory")
#define PG8_WAIT_L(n) asm volatile("s_waitcnt lgkmcnt(" #n ")" ::: "memory")
#define PG8_BAR __builtin_amdgcn_s_barrier()
#define PG8_SCHED __builtin_amdgcn_sched_barrier(0)
#define PG8_MKVA(u, v) do { _Pragma("unroll") for (int _h = 0; _h < 2; ++_h) _Pragma("unroll") for (int _i = 0; _i < 2; ++_i) { \
        if constexpr (Sched::GATHER) { const int _idx = _h * HALF + stR[_i]; const int _tk = (_idx < (u).nvalid) ? S.tok[(u).toff + _idx] : 0; (v)[_h][_i] = (unsigned)_tk * (unsigned)(K * 2) + (unsigned)(stC[_i] * 2); } \
        else (v)[_h][_i] = (unsigned)(_h * (int)hstep) + (unsigned)(stR[_i] * K + stC[_i]) * 2u; } } while (0)
    Unit cur, nxt; int ui = 0;
    if (!S.next(0, cur)) return;
    f32x4 acc[2][2][4][2];
#pragma unroll
    for (int a = 0; a < 2; ++a)
#pragma unroll
        for (int b = 0; b < 2; ++b)
#pragma unroll
            for (int m = 0; m < 4; ++m)
#pragma unroll
                for (int n = 0; n < 2; ++n) acc[a][b][m][n] = (f32x4){0.f, 0.f, 0.f, 0.f};
    bf16x8 At[4][2], B0[2][2], B1[2][2];
    unsigned vAc[2][2], vAn[2][2];
    PG8_MKVA(cur, vAc);
#define PG8_UA(u) (Sched::GATHER ? S.A : S.A + (size_t)(u).arow * (size_t)(K * 2))
#define PG8_UB(u) (S.B + (size_t)(u).brow * (size_t)(K * 2))
    const char* cA = uni_ptr(PG8_UA(cur)); const char* cB = uni_ptr(PG8_UB(cur));
    PG8_STAGE(PG8_SB(0, 0), cB, voffB); PG8_STAGE(PG8_SB(0, 1), cB + hstep, voffB); PG8_STAGE(PG8_SA(0, 0), cA, vAc[0]); PG8_STAGE(PG8_SA(0, 1), cA, vAc[1]);
    if (wr == 1) PG8_BAR;
    PG8_WAIT_V(2); PG8_BAR;
    PG8_STAGE(PG8_SB(1, 0), cB + kstep, voffB); PG8_STAGE(PG8_SA(1, 0), cA + kstep, vAc[0]); PG8_STAGE(PG8_SB(1, 1), cB + hstep + kstep, voffB);
    PG8_WAIT_V(6); PG8_BAR;
    for (;;) {
        const bool has_next = S.next(ui + 1, nxt);
        if (has_next) { PG8_MKVA(nxt, vAn); }
        else {
#pragma unroll
            for (int h = 0; h < 2; ++h)
#pragma unroll
                for (int i = 0; i < 2; ++i) vAn[h][i] = vAc[h][i];
        }
        const char* nA = has_next ? uni_ptr(PG8_UA(nxt)) : cA; const char* nB = has_next ? uni_ptr(PG8_UB(nxt)) : cB;
#pragma nounroll
        for (int t = 0; t < nt; t += 2) {
            const bool last = (t == nt - 2);
            const char* a1 = cA + (size_t)(t + 1) * kstep;
            const char* a2 = last ? nA : cA + (size_t)(t + 2) * kstep; const char* b2 = last ? nB : cB + (size_t)(t + 2) * kstep;
            const char* a3 = a2 + kstep; const char* b3 = b2 + kstep;
            unsigned v2[2][2];
#pragma unroll
            for (int h = 0; h < 2; ++h)
#pragma unroll
                for (int i = 0; i < 2; ++i) v2[h][i] = last ? vAn[h][i] : vAc[h][i];
            PG8_LDB(B0, 0, 0); PG8_LDB(B1, 0, 1); PG8_SCHED; PG8_LDA(At, 0, 0); PG8_STAGE(PG8_SA(1, 1), a1, vAc[1]);
            PG8_WAIT_V(8); PG8_WAIT_L(0); PG8_BAR; PG8_MMA(0, 0, At, B0); PG8_MMA(0, 1, At, B1); PG8_BAR; PG8_SCHED;
            PG8_LDA(At, 0, 1); PG8_STAGE(PG8_SB(0, 0), b2, voffB); PG8_STAGE(PG8_SB(0, 1), b2 + hstep, voffB); PG8_STAGE(PG8_SA(0, 0), a2, v2[0]);
            PG8_WAIT_V(8); PG8_WAIT_L(0); PG8_BAR; PG8_MMA(1, 0, At, B0); PG8_MMA(1, 1, At, B1); PG8_BAR; PG8_SCHED;
            PG8_LDB(B0, 1, 0); PG8_LDB(B1, 1, 1); PG8_SCHED; PG8_LDA(At, 1, 0); PG8_STAGE(PG8_SA(0, 1), a2, v2[1]);
            PG8_WAIT_V(8); PG8_WAIT_L(0); PG8_BAR; PG8_MMA(0, 0, At, B0); PG8_MMA(0, 1, At, B1); PG8_BAR; PG8_SCHED;
            PG8_LDA(At, 1, 1); PG8_STAGE(PG8_SB(1, 0), b3, voffB); PG8_STAGE(PG8_SB(1, 1), b3 + hstep, voffB); PG8_STAGE(PG8_SA(1, 0), a3, v2[0]);
            PG8_WAIT_V(8); PG8_WAIT_L(0); PG8_BAR; PG8_MMA(1, 0, At, B0); PG8_MMA(1, 1, At, B1); PG8_BAR; PG8_SCHED;
        }
        if (wr == 0) PG8_BAR;
        E(acc, cur, wr, wc, fr, fq);
        if (!has_next) break;
#pragma unroll
        for (int a = 0; a < 2; ++a)
#pragma unroll
            for (int b = 0; b < 2; ++b)
#pragma unroll
                for (int m = 0; m < 4; ++m)
#pragma unroll
                    for (int n = 0; n < 2; ++n) acc[a][b][m][n] = (f32x4){0.f, 0.f, 0.f, 0.f};
        cur = nxt; cA = nA; cB = nB; ++ui;
#pragma unroll
        for (int h = 0; h < 2; ++h)
#pragma unroll
            for (int i = 0; i < 2; ++i) vAc[h][i] = vAn[h][i];
        if (wr == 1) PG8_BAR;
    }
    PG8_WAIT_V(0);
    PG8_BAR;
#undef PG8_SA
#undef PG8_SB
#undef PG8_STAGE
#undef PG8_LDA
#undef PG8_LDB
#undef PG8_MMA
#undef PG8_WAIT_V
#undef PG8_WAIT_L
#undef PG8_BAR
#undef PG8_SCHED
#undef PG8_MKVA
#undef PG8_UA
#undef PG8_UB
}
}

#define XB_TMO      128
#define XB_XCNT(j)  (256  + 64 * (j))
#define XB_XSUB(j)  (1280 + 64 * (j))
#define XB_XGEN(j)  (2304 + 64 * (j))
#define XB_TOP      3328
#define XB_TOPGEN   3392
#define XCD_BAR_WORDS 3456
#define XB_SPIN_CAP (1u << 18)
__device__ __forceinline__ unsigned xb_ld(unsigned* p)              { return __hip_atomic_load(p, __ATOMIC_RELAXED, __HIP_MEMORY_SCOPE_AGENT); }
__device__ __forceinline__ unsigned xb_add(unsigned* p, unsigned v) { return __hip_atomic_fetch_add(p, v, __ATOMIC_RELAXED, __HIP_MEMORY_SCOPE_AGENT); }
__device__ __forceinline__ unsigned xb_xcc_id() { return (unsigned)__builtin_amdgcn_s_getreg((3 << 11) | 20) & 0xFu; }
#define XB_SPIN(cond, bar) do { unsigned _sp = 0; while (cond) { __builtin_amdgcn_s_sleep(1); \
    if ((++_sp & 255u) == 0u) { if (xb_ld(&(bar)[XB_TMO])) break; if (_sp > XB_SPIN_CAP) { atomicAdd(&(bar)[XB_TMO], 1u); break; } } } } while (0)
struct XcdBarrier { unsigned* bar; unsigned x; volatile LAS unsigned* st; };
__device__ __forceinline__ XcdBarrier xcd_barrier_post(unsigned* bar, volatile LAS unsigned* st) {
    XcdBarrier b; b.bar = bar; b.x = xb_xcc_id(); b.st = st;
    if (threadIdx.x == 0) (void)xb_add(&bar[XB_XCNT(b.x)], 1u);
    return b;
}
__device__ __forceinline__ void xcd_barrier_complete(unsigned* bar, unsigned x, unsigned& nloc, unsigned& nx) {
    const unsigned G = gridDim.x * gridDim.y * gridDim.z;
    unsigned sum, cnt, mine, sp = 0u;
    for (;;) {
        sum = 0u; cnt = 0u; mine = 0u;
#pragma unroll
        for (unsigned j = 0; j < 16; ++j) { const unsigned c = xb_ld(&bar[XB_XCNT(j)]); sum += c; cnt += (c > 0u) ? 1u : 0u; mine = (j == x) ? c : mine; }
        if (sum == G) break;
        __builtin_amdgcn_s_sleep(1);
        if ((++sp & 255u) == 0u) { if (xb_ld(&bar[XB_TMO])) break; if (sp > XB_SPIN_CAP) { atomicAdd(&bar[XB_TMO], 1u); break; } }
    }
    nloc = mine > 0u ? mine : 1u; nx = cnt > 0u ? cnt : 1u;
}
__device__ __forceinline__ void xcd_barrier(const XcdBarrier& b) {
    asm volatile("s_waitcnt vmcnt(0)" ::: "memory");
    __syncthreads();
    if (threadIdx.x == 0) {
        unsigned* bar = b.bar;
        __builtin_amdgcn_s_waitcnt(0);
        unsigned nloc = b.st[0], nx = b.st[1];
        if (nloc == 0u) { xcd_barrier_complete(bar, b.x, nloc, nx); b.st[0] = nloc; b.st[1] = nx; }
        const unsigned old = xb_add(&bar[XB_XSUB(b.x)], 1u);
        const unsigned gen = old / nloc;
        if (old + 1u == (gen + 1u) * nloc) {
            __builtin_amdgcn_fence(__ATOMIC_RELEASE, "agent");
            asm volatile("s_waitcnt vmcnt(0)" ::: "memory");
            const unsigned og = xb_add(&bar[XB_TOP], 1u);
            const unsigned tg = og / nx;
            if (og + 1u == (tg + 1u) * nx) xb_add(&bar[XB_TOPGEN], 1u);
            else XB_SPIN(xb_ld(&bar[XB_TOPGEN]) == tg, bar);
            __builtin_amdgcn_fence(__ATOMIC_ACQUIRE, "agent");
            xb_add(&bar[XB_XGEN(b.x)], 1u);
            asm volatile("s_waitcnt vmcnt(0)" ::: "memory");
        } else {
            XB_SPIN(xb_ld(&bar[XB_XGEN(b.x)]) == gen, bar);
            __builtin_amdgcn_fence(__ATOMIC_ACQUIRE, "agent");
            asm volatile("s_waitcnt vmcnt(0)" ::: "memory");
        }
    }
    __syncthreads();
}

struct Args { const float* in[24]; float* out; unsigned char* ws; int ph_lo, ph_hi; };
enum { I_X = 0, I_C, I_N1G, I_WIN, I_WG2, I_BG, I_GONG, I_LNG, I_LNB, I_SWS, I_SBS, I_SONG, I_WOUT, I_N2G, I_RGW, I_RGB, I_REW, I_REB, I_EWG, I_EWU, I_EWD, I_ADAW, I_ADAB, I_FING };

struct Ctx {
    LAS unsigned char* lds;
    int tid, lane, wave, G, bid;
    const float* const* in;
    unsigned char* ws;
    float* out;
};

struct EpiInProj {
    static constexpr bool PERM = true;
    bf16_t* P; const float* bg;
    template <int MODE> __device__ __forceinline__ void run(const f32x4 (&acc)[2][2][4][2], const pg8::Unit& u, int wr, int wc, int fr, int fq) const {
        const int row0 = u.row0 + wr * 64 + fr, col0 = u.col0 + wc * 32 + 8 * fq;
        f32x4 bv[2][2];
#pragma unroll
        for (int bj = 0; bj < 2; ++bj)
#pragma unroll
            for (int n = 0; n < 2; ++n) bv[bj][n] = (MODE == 2) ? *(const f32x4*)(bg + (col0 - PG) + bj * 128 + 4 * n) : (f32x4){0.f, 0.f, 0.f, 0.f};
#pragma unroll
        for (int ai = 0; ai < 2; ++ai)
#pragma unroll
            for (int m = 0; m < 4; ++m) {
                bf16_t* rowp = P + (size_t)(row0 + ai * 128 + m * 16) * NP + col0;
#pragma unroll
                for (int bj = 0; bj < 2; ++bj) {
                    float v[8];
#pragma unroll
                    for (int n = 0; n < 2; ++n)
#pragma unroll
                        for (int j = 0; j < 4; ++j) {
                            float x = acc[ai][bj][m][n][j];
                            if (MODE == 0) x *= 0.125f;
                            else if (MODE == 2) x = logsig_f(x + bv[bj][n][j]) * 0.0625f;
                            else if (MODE == 3) x = silu_f(x);
                            else if (MODE == 4) x = gelu_tanh_f(x);
                            v[n * 4 + j] = x;
                        }
                    u32x4 w; w.x = cvt_pk_bf16(v[0], v[1]); w.y = cvt_pk_bf16(v[2], v[3]); w.z = cvt_pk_bf16(v[4], v[5]); w.w = cvt_pk_bf16(v[6], v[7]);
                    *(u32x4*)(rowp + bj * 128) = w;
                }
            }
    }
    __device__ __forceinline__ void operator()(const f32x4 (&acc)[2][2][4][2], const pg8::Unit& u, int wr, int wc, int fr, int fq) const {
        const int pn = u.col0 >> 8;
        if (pn == 0) run<0>(acc, u, wr, wc, fr, fq);
        else if (pn == 2) run<2>(acc, u, wr, wc, fr, fq);
        else if (pn == 5 || pn == 6) run<3>(acc, u, wr, wc, fr, fq);
        else if (pn >= 7) run<4>(acc, u, wr, wc, fr, fq);
        else run<1>(acc, u, wr, wc, fr, fq);
    }
};

struct EpiOutProj {
    static constexpr bool PERM = true;
    const float* xin; float* xout; const float* gate;
    __device__ __forceinline__ void operator()(const f32x4 (&acc)[2][2][4][2], const pg8::Unit& u, int wr, int wc, int fr, int fq) const {
        const int row0 = u.row0 + wr * 64 + fr, col0 = u.col0 + wc * 32 + 8 * fq;
        const float* g = gate + (u.row0 >= SEQ ? 6144 : 0) + col0;
        f32x4 gv[2][2];
#pragma unroll
        for (int bj = 0; bj < 2; ++bj)
#pragma unroll
            for (int n = 0; n < 2; ++n) gv[bj][n] = *(const f32x4*)(g + bj * 128 + 4 * n);
#pragma unroll
        for (int ai = 0; ai < 2; ++ai)
#pragma unroll
            for (int m = 0; m < 4; ++m) {
                const size_t off = (size_t)(row0 + ai * 128 + m * 16) * D + col0;
#pragma unroll
                for (int bj = 0; bj < 2; ++bj)
#pragma unroll
                    for (int n = 0; n < 2; ++n) {
                        const f32x4 xo = *(const f32x4*)(xin + off + bj * 128 + 4 * n);
                        *(f32x4*)(xout + off + bj * 128 + 4 * n) = xo + gv[bj][n] * acc[ai][bj][m][n];
                    }
            }
    }
};

struct EpiMoe1 {
    static constexpr bool PERM = true;
    bf16_t* ACT; const float* wl;
    __device__ __forceinline__ void operator()(const f32x4 (&acc)[2][2][4][2], const pg8::Unit& u, int wr, int wc, int fr, int fq) const {
        const int col0 = u.col0 + wc * 32 + 8 * fq;
#pragma unroll
        for (int ai = 0; ai < 2; ++ai)
#pragma unroll
            for (int m = 0; m < 4; ++m) {
                const int rt = ai * 128 + wr * 64 + m * 16 + fr;
                if (rt < u.nvalid) {
                    const float w = wl[u.toff + rt];
                    float v[8];
#pragma unroll
                    for (int n = 0; n < 2; ++n)
#pragma unroll
                        for (int j = 0; j < 4; ++j) v[n * 4 + j] = silu_f(acc[ai][0][m][n][j]) * acc[ai][1][m][n][j] * w;
                    u32x4 o; o.x = cvt_pk_bf16(v[0], v[1]); o.y = cvt_pk_bf16(v[2], v[3]); o.z = cvt_pk_bf16(v[4], v[5]); o.w = cvt_pk_bf16(v[6], v[7]);
                    *(u32x4*)(ACT + (size_t)(u.row0 + rt) * 256 + col0) = o;
                }
            }
    }
};

struct EpiMoe2 {
    static constexpr bool PERM = true;
    bf16_t* Y;
    __device__ __forceinline__ void operator()(const f32x4 (&acc)[2][2][4][2], const pg8::Unit& u, int wr, int wc, int fr, int fq) const {
        const int col0 = u.col0 + wc * 32 + 8 * fq;
#pragma unroll
        for (int ai = 0; ai < 2; ++ai)
#pragma unroll
            for (int m = 0; m < 4; ++m) {
                const int rt = ai * 128 + wr * 64 + m * 16 + fr;
                if (rt < u.nvalid) {
                    bf16_t* rowp = Y + (size_t)(u.row0 + rt) * D + col0;
#pragma unroll
                    for (int bj = 0; bj < 2; ++bj) {
                        const f32x4 v0 = acc[ai][bj][m][0], v1 = acc[ai][bj][m][1];
                        u32x4 o; o.x = cvt_pk_bf16(v0[0], v0[1]); o.y = cvt_pk_bf16(v0[2], v0[3]); o.z = cvt_pk_bf16(v1[0], v1[1]); o.w = cvt_pk_bf16(v1[2], v1[3]);
                        *(u32x4*)(rowp + bj * 128) = o;
                    }
                }
            }
    }
};

struct MoeTables { const LAS int* tp; const LAS int* cnt; const LAS int* base; const LAS int* ue; };
#define RFL(x) __builtin_amdgcn_readfirstlane(x)
struct MoeSched1 {
    static constexpr bool GATHER = true;
    MoeTables tb; const char* A; const char* B; const int* tok; int G, c;
    __device__ __forceinline__ bool next(int i, pg8::Unit& u) const {
        if (i >= 16) return false;
        const int e = RFL(tb.ue[i]); if (e < 0) return false;
        const int L = i * G + c, tile = L >> 1, nt = L & 1;
        const int mt = tile - RFL(tb.tp[e]); const int nv = RFL(tb.cnt[e]) - mt * 256;
        u.arow = 0; u.brow = e * 512 + nt * 256; u.row0 = RFL(tb.base[e]) + mt * 256; u.col0 = nt * 128; u.nvalid = nv < 256 ? nv : 256; u.toff = e * T + mt * 256; return true;
    }
};
struct MoeSched2 {
    static constexpr bool GATHER = false;
    MoeTables tb; const char* A; const char* B; const int* tok; int G, c;
    __device__ __forceinline__ bool next(int i, pg8::Unit& u) const {
        if (i >= 16) return false;
        const int e = RFL(tb.ue[i]); if (e < 0) return false;
        const int L = i * G + c, tile = L >> 2, nt = L & 3;
        const int mt = tile - RFL(tb.tp[e]); const int nv = RFL(tb.cnt[e]) - mt * 256;
        u.row0 = RFL(tb.base[e]) + mt * 256; u.arow = u.row0; u.brow = e * 1024 + nt * 256; u.col0 = nt * 256; u.nvalid = nv < 256 ? nv : 256; u.toff = 0; return true;
    }
};

__global__ void __launch_bounds__(NWAVES * 64, 2) fwd_kernel(Args args) {
    extern __shared__ __attribute__((aligned(16))) unsigned char lds_raw[];
    LAS unsigned char* lds = (LAS unsigned char*)lds_raw;
    const int tid0 = threadIdx.x, G0 = gridDim.x, bid0 = blockIdx.x;
#define PHASE_BEGIN() \
    int tid = tid0, bid = bid0, G = G0, l = l0; \
    asm volatile("" : "+v"(tid), "+s"(bid), "+s"(G), "+s"(l) :: "memory"); KSEG_FENCE(); \
    const int lane = tid & 63, wave = __builtin_amdgcn_readfirstlane(tid >> 6), gw = bid * NWAVES + wave, NGW = G * NWAVES; \
    const float* modl = MOD + (size_t)l * 2 * 6144; (void)lane; (void)wave; (void)gw; (void)NGW; (void)modl
    const CAS unsigned char* kseg = (const CAS unsigned char*)__builtin_amdgcn_kernarg_segment_ptr();
#define KSEG_FENCE() asm volatile("" : "+s"(kseg) :: "memory")
#define KIN(i) (*(const float* const CAS*)(kseg + 8 * (i)))
#define K_OUT (*(float* const CAS*)(kseg + 192))
#define K_WS (*(unsigned char* const CAS*)(kseg + 200))
#define WSP(type, off) ((type*)(K_WS + (off)))
#define ctl WSP(unsigned, WS_CTL)
#define MOD WSP(float, WS_MOD)
#define WRH WSP(bf16_t, WS_WRH)
#define WRL WSP(bf16_t, WS_WRL)
#define SHW WSP(float, WS_SHW)
#define TOK WSP(int, WS_TOK)
#define WL WSP(float, WS_WL)
#define REF WSP(int, WS_REF)
#define DECAY WSP(float, WS_DECAY)
#define WIN WSP(bf16_t, WS_WIN)
#define WOUT WSP(bf16_t, WS_WOUT)
#define WGU WSP(bf16_t, WS_WGU)
#define WD WSP(bf16_t, WS_WD)
#define H WSP(bf16_t, WS_H)
#define P WSP(bf16_t, WS_P)
#define Y WSP(bf16_t, WS_Y)
#define KVT WSP(float, WS_KVT)
#define ACT WSP(bf16_t, WS_ACT)
#define ST WSP(bf16_t, WS_ST)
#define OMIX WSP(bf16_t, WS_OMIX)
#define VT WSP(bf16_t, WS_VT)
#define XOUT K_OUT
    volatile LAS unsigned* MISC = (volatile LAS unsigned*)(lds + MISC_OFF);
    LAS int* TB_TP = (LAS int*)(lds + MISC_OFF + 64);
    LAS int* TB_CNT = (LAS int*)(lds + MISC_OFF + 256);
    LAS int* TB_BASE = (LAS int*)(lds + MISC_OFF + 448);
    LAS int* TB_UE = (LAS int*)(lds + MISC_OFF + 640);

    for (int u = tid0; u < 256; u += NWAVES * 64) ((LAS unsigned*)(lds + MISC_OFF))[u] = 0u;
    __syncthreads();
    unsigned my_xcc = 0;
    if (!MK_SPLIT) { XcdBarrier b0 = xcd_barrier_post(ctl + CW_BAR, MISC + 0); my_xcc = b0.x; }
    const int lo = *(const int CAS*)(kseg + 208), hi = *(const int CAS*)(kseg + 212);
#ifndef PHMASK
#define PHMASK 0x7ff
#endif
#define PHT(k) ((k) < 2 ? (k) : 2 + ((k) - 2) % 9)
#define IN(k) (((PHMASK >> PHT(k)) & 1) && lo <= (k) && (k) < hi)
#ifndef DUPMASK
#define DUPMASK 0
#endif
#define NREP(k) (1 + ((DUPMASK >> PHT(k)) & 1))
#define REP_BEGIN(k) for (int _rep = 0; _rep < NREP(k); ++_rep) { const bool dry = (NREP(k) > 1) && (_rep == 0); (void)dry; if (_rep) { KSEG_FENCE(); XcdBarrier _b; _b.bar = ctl + CW_BAR; _b.x = my_xcc; _b.st = MISC; xcd_barrier(_b); }
#define REP_END() }
#define SEAM(k) do { if (IN(k) && IN((k) + 1)) { KSEG_FENCE(); XcdBarrier _b; _b.bar = ctl + CW_BAR; _b.x = my_xcc; _b.st = MISC; xcd_barrier(_b); } KSEG_FENCE(); } while (0)

    if (IN(0)) { REP_BEGIN(0)
        const int l0 = 0; PHASE_BEGIN();
        {
            LAS float* cact = (LAS float*)lds;
            LAS float* part = (LAS float*)(lds + 8192);
            for (int i = tid; i < 2 * D; i += NWAVES * 64) cact[i] = silu_f(KIN(I_C)[i]);
            __syncthreads();
            const int jj = tid & 63, ks = tid >> 6;
            for (int item = bid; item < DEPTH * 96; item += G) {
                const int l = item / 96, j0 = (item % 96) * 64;
                const float* w = KIN(I_ADAW) + (size_t)l * D * 6144 + (size_t)(ks * 128) * 6144 + j0 + jj;
                float a0 = 0.f, a1 = 0.f;
#pragma unroll 8
                for (int k = 0; k < 128; ++k) { const float wv = w[(size_t)k * 6144]; a0 += cact[ks * 128 + k] * wv; a1 += cact[D + ks * 128 + k] * wv; }
                part[(ks * 64 + jj) * 2 + 0] = a0; part[(ks * 64 + jj) * 2 + 1] = a1;
                __syncthreads();
                if (tid < 128) { const int j = tid & 63, b = tid >> 6; float s = KIN(I_ADAB)[l * 6144 + j0 + j];
#pragma unroll
                    for (int q = 0; q < 8; ++q) s += part[(q * 64 + j) * 2 + b];
                    MOD[(size_t)(l * 2 + b) * 6144 + j0 + j] = s; }
                __syncthreads();
            }
        }
        {
            for (int i = bid * (NWAVES * 64) + tid; i < DEPTH * 64 * D; i += G * NWAVES * 64) {
                const int l = i / (64 * D), r = i % (64 * D), e = r / D, k = r % D;
                const float w = (e < 32) ? KIN(I_REW)[((size_t)l * D + k) * 32 + e] : ((e < 36) ? KIN(I_RGW)[((size_t)l * D + k) * 4 + (e - 32)] : 0.f);
                const bf16_t hi = f2bf(w); WRH[i] = hi; WRL[i] = f2bf(w - bf2f(hi));
            }
        }
        {
            LAS float* scr = (LAS float*)(lds + wave * 16384);
            constexpr int NI_IN = 16 * 88, NI_OUT = 16 * 32, NI_GU = 32 * 2 * 16 * 8, NI_DN = 32 * 4 * 32, NL = NI_IN + NI_OUT + NI_GU + NI_DN;
            for (int it = gw; it < DEPTH * NL; it += NGW) {
                const int l = it / NL; int r = it % NL;
                const float* src; int lds_src; bf16_t* dst; int ld_dst; bool gk = false; int gk_n0 = 0, gk_k0 = 0;
                if (r < NI_IN) { const int kb = r / 88, db = r % 88, n0 = 32 * db;
                    dst = WIN + ((size_t)l * NP + n0) * D + 64 * kb; ld_dst = D; lds_src = INC;
                    if (db >= 16 && db < 24) { gk = true; gk_n0 = n0 - PG; gk_k0 = 64 * kb; src = KIN(I_WIN) + (size_t)l * D * INC; }
                    else { const int sc = n0 < 512 ? n0 : (n0 < PU ? n0 - 256 : n0 - 240); src = KIN(I_WIN) + (size_t)l * D * INC + (size_t)(64 * kb) * INC + sc; }
                } else if ((r -= NI_IN) < NI_OUT) { const int kb = r / 32, nb = r % 32;
                    src = KIN(I_WOUT) + (size_t)l * D * D + (size_t)(64 * kb) * D + 32 * nb; lds_src = D; dst = WOUT + ((size_t)l * D + 32 * nb) * D + 64 * kb; ld_dst = D;
                } else if ((r -= NI_OUT) < NI_GU) { const int e = r / 256, q = r % 256, which = q / 128, q2 = q % 128, kb = q2 / 8, nb = q2 % 8, f0 = 32 * nb;
                    const int drow = (f0 >> 7) * 256 + which * 128 + (f0 & 127);
                    src = KIN(which ? I_EWU : I_EWG) + ((size_t)(l * 32 + e) * D + 64 * kb) * 256 + f0; lds_src = 256;
                    dst = WGU + ((size_t)(l * 32 + e) * 512 + drow) * D + 64 * kb; ld_dst = D;
                } else { r -= NI_GU; const int e = r / 128, q = r % 128, kb = q / 32, nb = q % 32;
                    src = KIN(I_EWD) + ((size_t)(l * 32 + e) * 256 + 64 * kb) * D + 32 * nb; lds_src = D;
                    dst = WD + ((size_t)(l * 32 + e) * D + 32 * nb) * 256 + 64 * kb; ld_dst = 256;
                }
                if (gk) {
                    const float* wg2 = KIN(I_WG2) + (size_t)l * 16 * 256;
#pragma unroll 4
                    for (int i = 0; i < 32; ++i) { const int kk = 2 * i + (lane >> 5), nn = lane & 31; const float* wl = src + (size_t)(gk_k0 + kk) * INC + 1536; float s = 0.f;
#pragma unroll
                        for (int q = 0; q < 16; ++q) s += wl[q] * wg2[q * 256 + gk_n0 + nn];
                        scr[kk * 33 + nn] = s; }
                } else {
#pragma unroll 8
                    for (int i = 0; i < 32; ++i) { const int kk = 2 * i + (lane >> 5); scr[kk * 33 + (lane & 31)] = src[(size_t)kk * lds_src + (lane & 31)]; }
                }
                LDS_WAIT(); asm volatile("" ::: "memory");
                const int c = lane & 7;
#pragma unroll
                for (int j = 0; j < 4; ++j) { const int n = (lane >> 3) + 8 * j; const LAS float* s = scr + (8 * c) * 33 + n;
                    u32x4 o; o.x = cvt_pk_bf16(s[0 * 33], s[1 * 33]); o.y = cvt_pk_bf16(s[2 * 33], s[3 * 33]); o.z = cvt_pk_bf16(s[4 * 33], s[5 * 33]); o.w = cvt_pk_bf16(s[6 * 33], s[7 * 33]);
                    *(u32x4*)(dst + (size_t)n * ld_dst + 8 * c) = o; }
                LDS_WAIT(); asm volatile("" ::: "memory");
            }
        }
    REP_END() }
    SEAM(0);

#define NORM_ROW(xrow, hrow, gp, scp, shp) do { \
        f32x4 _v[4]; float _s = 0.f; \
        _Pragma("unroll") for (int _j = 0; _j < 4; ++_j) { _v[_j] = *((const f32x4*)(xrow) + lane + 64 * _j); _s += (_v[_j].x * _v[_j].x + _v[_j].y * _v[_j].y) + (_v[_j].z * _v[_j].z + _v[_j].w * _v[_j].w); } \
        const float _r = __builtin_amdgcn_rsqf(wave_sum(_s) * (1.f / D) + EPS); \
        _Pragma("unroll") for (int _j = 0; _j < 4; ++_j) { const f32x4 _g = *((const f32x4*)(gp) + lane + 64 * _j), _sc = *((const f32x4*)(scp) + lane + 64 * _j), _sh = *((const f32x4*)(shp) + lane + 64 * _j); \
            const f32x4 _h = (_v[_j] * _r) * _g * (_sc + 1.f) + _sh; u32x2 _o; _o.x = cvt_pk_bf16(_h.x, _h.y); _o.y = cvt_pk_bf16(_h.z, _h.w); *((u32x2*)(hrow) + lane + 64 * _j) = _o; } } while (0)

    if (IN(1)) { REP_BEGIN(1)
        const int l0 = 0; PHASE_BEGIN();
        for (int m = gw; m < T; m += NGW) { const float* md = MOD + (size_t)(m >= SEQ ? 1 : 0) * 6144;
            NORM_ROW(KIN(I_X) + (size_t)m * D, H + (size_t)m * D, KIN(I_N1G), md + 1024, md); }
        for (int it = gw; it < DEPTH * 2 * 36; it += NGW) {
            const int ll = it / 72, b = (it % 72) / 36, e = it % 36;
            const float* sh = MOD + (size_t)(ll * 2 + b) * 6144 + 3072; float s = 0.f;
            for (int k = lane; k < D; k += 64) s += sh[k] * ((e < 32) ? KIN(I_REW)[((size_t)ll * D + k) * 32 + e] : KIN(I_RGW)[((size_t)ll * D + k) * 4 + (e - 32)]);
            s = wave_sum(s);
            if (lane == 0) SHW[(ll * 2 + b) * 64 + e] = s + ((e < 32) ? KIN(I_REB)[ll * 32 + e] : KIN(I_RGB)[ll * 4 + (e - 32)]);
        }
    REP_END() }
    SEAM(1);

    for (int l0 = 0; l0 < DEPTH; ++l0) {
        const int pb = 2 + 9 * l0;
        if (IN(pb + 0)) { REP_BEGIN(pb + 0)
            PHASE_BEGIN();
            pg8::DenseSched S; S.init(H, WIN + (size_t)l * NP * D, T, NP, G, bid);
            EpiInProj E{P, KIN(I_BG) + l * 256};
            pg8::gemm_phase<EpiInProj, pg8::DenseSched>(lds, tid, D, S, E);
        REP_END() }
        SEAM(pb + 0);

        if (IN(pb + 1)) { REP_BEGIN(pb + 1)
            PHASE_BEGIN();
#if MFMA_G1
            {
                LAS unsigned char* ET = lds;
                LAS unsigned char* VI = lds + 9216;
                LAS float* segtot = (LAS float*)(lds + 9216 + 17408);
                const int col = tid & 63, seg = tid >> 6;
                const int r32 = lane & 31, hf = lane >> 5, blk16 = (lane >> 4) & 1, tq = (lane & 15) >> 2, tp = lane & 3;
                for (int unit = bid; unit < NCH * 4; unit += G) {
                    const int cn = unit >> 2, hh = unit & 3;
                    bf16_t* Pc = P + (size_t)(cn * 64) * NP; bf16_t* Pw = dry ? Pc + (WS_DRY - WS_P) / 2 : Pc;
                    float g[8], kk[8], qq[8]; float run = 0.f;
#pragma unroll
                    for (int i = 0; i < 8; ++i) { const size_t ro = (size_t)(seg * 8 + i) * NP; run += bf2f(Pc[ro + PG + hh * 64 + col]); g[i] = run; kk[i] = bf2f(Pc[ro + PK + hh * 64 + col]); qq[i] = bf2f(Pc[ro + PQ + hh * 64 + col]); }
                    segtot[seg * 64 + col] = run;
#pragma unroll
                    for (int i = 0; i < 2; ++i) { const int idx = tid + 512 * i, row = idx >> 4, ch = idx & 15;
                        *(LAS u32x4*)(VI + row * 272 + ch * 16) = *(const u32x4*)(Pc + (size_t)row * NP + PV + hh * 128 + ch * 8); }
                    __syncthreads();
                    float offs = 0.f, blast = 0.f;
#pragma unroll
                    for (int s = 0; s < 8; ++s) { const float tv = segtot[s * 64 + col]; if (s < seg) offs += tv; blast += tv; }
                    float ke[8];
#pragma unroll
                    for (int i = 0; i < 8; ++i) { const float bb = offs + g[i]; const size_t ro = (size_t)(seg * 8 + i) * NP;
                        Pw[ro + PQ + hh * 64 + col] = f2bf(qq[i] * __expf(bb)); Pw[ro + PK + hh * 64 + col] = f2bf(kk[i] * __expf(-bb)); ke[i] = kk[i] * __expf(blast - bb); }
                    *(LAS bf16x8*)(ET + col * 144 + seg * 16) = pack8(ke[0], ke[1], ke[2], ke[3], ke[4], ke[5], ke[6], ke[7]);
                    if (seg == 0) DECAY[(size_t)unit * 64 + col] = __expf(blast);
                    __syncthreads();
                    {
                        const int vt = wave >> 1, kt = wave & 1;
                        f32x16 acc;
#pragma unroll
                        for (int r = 0; r < 16; ++r) acc[r] = 0.f;
#pragma unroll
                        for (int ks = 0; ks < 4; ++ks) {
                            const LAS unsigned char* ta = VI + (16 * ks + 8 * hf + tq) * 272 + (32 * vt + 16 * blk16 + 4 * tp) * 2;
                            const bf16x8 a = cat4(lds_tr(ta), lds_tr(ta + 4 * 272));
                            const bf16x8 b = *(const LAS bf16x8*)(ET + (32 * kt + r32) * 144 + (16 * ks + 8 * hf) * 2);
                            acc = MFMA32(a, b, acc);
                            if (kt == 0) *(bf16x8*)(VT + ((size_t)unit * 128 + 32 * vt + r32) * 64 + 16 * ks + 8 * hf) = a;
                        }
#pragma unroll
                        for (int r = 0; r < 16; ++r) KVT[((size_t)unit * 128 + 32 * vt + (r & 3) + 8 * (r >> 2) + 4 * hf) * 64 + 32 * kt + r32] = acc[r];
                    }
                    __syncthreads();
                }
            }
#else
            {
                LAS float* ke = (LAS float*)lds;
                LAS float* vv = (LAS float*)(lds + 16384);
                LAS float* segtot = (LAS float*)(lds + 49152);
                const int col = tid & 63, seg = tid >> 6;
                for (int unit = bid; unit < NCH * 4; unit += G) {
                    const int cn = unit >> 2, h = unit & 3;
                    bf16_t* Pc = P + (size_t)(cn * 64) * NP;
                    float g[8], kk[8], qq[8]; float run = 0.f;
#pragma unroll
                    for (int i = 0; i < 8; ++i) { const size_t ro = (size_t)(seg * 8 + i) * NP; run += bf2f(Pc[ro + PG + h * 64 + col]); g[i] = run; kk[i] = bf2f(Pc[ro + PK + h * 64 + col]); qq[i] = bf2f(Pc[ro + PQ + h * 64 + col]); }
                    segtot[seg * 64 + col] = run;
#pragma unroll
                    for (int i = 0; i < 16; ++i) { const int idx = tid + 512 * i, p = idx >> 7, vd = idx & 127; vv[p * 128 + vd] = bf2f(Pc[(size_t)p * NP + PV + h * 128 + vd]); }
                    __syncthreads();
                    float offs = 0.f, blast = 0.f;
#pragma unroll
                    for (int s = 0; s < 8; ++s) { const float tv = segtot[s * 64 + col]; if (s < seg) offs += tv; blast += tv; }
#pragma unroll
                    for (int i = 0; i < 8; ++i) { const float bb = offs + g[i]; const size_t ro = (size_t)(seg * 8 + i) * NP;
                        Pc[ro + PQ + h * 64 + col] = f2bf(qq[i] * __expf(bb)); Pc[ro + PK + h * 64 + col] = f2bf(kk[i] * __expf(-bb)); ke[(seg * 8 + i) * 64 + col] = kk[i] * __expf(blast - bb); }
                    if (seg == 0) DECAY[(size_t)(cn * 4 + h) * 64 + col] = __expf(blast);
#pragma unroll
                    for (int i = 0; i < 16; ++i) { const int idx = tid + 512 * i, vd = idx >> 6, j = idx & 63; VT[((size_t)unit * 128 + vd) * 64 + j] = f2bf(vv[j * 128 + vd]); }
                    __syncthreads();
                    {
                        const int vd = tid & 127, kd0 = (tid >> 7) * 16; float a[16];
#pragma unroll
                        for (int q = 0; q < 16; ++q) a[q] = 0.f;
                        for (int j = 0; j < 64; ++j) { const float x = vv[j * 128 + vd];
#pragma unroll
                            for (int q = 0; q < 16; ++q) a[q] += ke[j * 64 + kd0 + q] * x; }
                        float* o = KVT + ((size_t)(cn * 4 + h) * 128 + vd) * 64 + kd0;
#pragma unroll
                        for (int q = 0; q < 4; ++q) *(f32x4*)(o + 4 * q) = (f32x4){a[4 * q], a[4 * q + 1], a[4 * q + 2], a[4 * q + 3]};
                    }
                    __syncthreads();
                }
            }
#endif
#if MFMA_SGU
            for (int _r2 = 0; _r2 < 1 + ((DUPMASK >> 12) & 1); ++_r2)
            {
                LAS unsigned char* vimg = lds;
                const float* lng = KIN(I_LNG) + l * 512; const float* lnb = KIN(I_LNB) + l * 512;
                const int r32 = lane & 31, hf = lane >> 5, blk16 = (lane >> 4) & 1, tq = (lane & 15) >> 2, tp = lane & 3;
                for (int unit = bid; unit < 256; unit += G) {
                    const int gp = unit & 1, blk = (unit >> 1) & 63, b = unit >> 7;
                    const int t0 = b * SEQ + blk * 128;
                    {
                        const int row = tid >> 2, part = tid & 3;
                        const bf16_t* pr = P + (size_t)(t0 + row) * NP + PSV;
                        float s = 0.f, s2 = 0.f;
#pragma unroll 4
                        for (int c = 0; c < 128; c += 8) { const u32x4 w = *(const u32x4*)(pr + part * 128 + c);
#pragma unroll
                            for (int q = 0; q < 4; ++q) { const float x0 = bflo(w[q]), x1 = bfhi(w[q]); s += x0 + x1; s2 += x0 * x0 + x1 * x1; } }
                        s += __shfl_xor(s, 1); s += __shfl_xor(s, 2); s2 += __shfl_xor(s2, 1); s2 += __shfl_xor(s2, 2);
                        const float mean = s * (1.f / 512.f); const float var = fmaxf(s2 * (1.f / 512.f) - mean * mean, 0.f); const float rstd = __builtin_amdgcn_rsqf(var + EPS);
                        const int cb = 256 * gp + 64 * part;
#pragma unroll
                        for (int c8 = 0; c8 < 8; ++c8) { const u32x4 w = *(const u32x4*)(pr + cb + 8 * c8);
                            const f32x4 g0 = *(const f32x4*)(lng + cb + 8 * c8), g1 = *(const f32x4*)(lng + cb + 8 * c8 + 4), b0 = *(const f32x4*)(lnb + cb + 8 * c8), b1 = *(const f32x4*)(lnb + cb + 8 * c8 + 4);
                            *(LAS bf16x8*)(vimg + row * 528 + (64 * part + 8 * c8) * 2) = pack8(
                                (bflo(w[0]) - mean) * rstd * g0[0] + b0[0], (bfhi(w[0]) - mean) * rstd * g0[1] + b0[1], (bflo(w[1]) - mean) * rstd * g0[2] + b0[2], (bfhi(w[1]) - mean) * rstd * g0[3] + b0[3],
                                (bflo(w[2]) - mean) * rstd * g1[0] + b1[0], (bfhi(w[2]) - mean) * rstd * g1[1] + b1[1], (bflo(w[3]) - mean) * rstd * g1[2] + b1[2], (bfhi(w[3]) - mean) * rstd * g1[3] + b1[3]); }
                    }
                    __syncthreads();
                    {
                        const int gs = wave >> 2, it = wave & 3, g = 2 * gp + gs;
                        f32x16 acc[4];
#pragma unroll
                        for (int ct = 0; ct < 4; ++ct)
#pragma unroll
                            for (int r = 0; r < 16; ++r) acc[ct][r] = 0.f;
                        const float* wrow = KIN(I_SWS) + ((size_t)(l * 4 + g) * 128 + 32 * it + r32) * 128 + 8 * hf;
                        const LAS unsigned char* tbase = vimg + (8 * hf + tq) * 528 + (128 * gs + 16 * blk16 + 4 * tp) * 2;
                        const int nks = (it < 2) ? 4 : 8;
                        for (int ks = 0; ks < nks; ++ks) {
                            const f32x4 w0 = *(const f32x4*)(wrow + 16 * ks), w1 = *(const f32x4*)(wrow + 16 * ks + 4);
                            const bf16x8 bw = pack8(w0[0], w0[1], w0[2], w0[3], w1[0], w1[1], w1[2], w1[3]);
#pragma unroll
                            for (int ct = 0; ct < 4; ++ct) { const LAS unsigned char* ta = tbase + (16 * ks) * 528 + (32 * ct) * 2;
                                acc[ct] = MFMA32(cat4(lds_tr(ta), lds_tr(ta + 4 * 528)), bw, acc[ct]); }
                        }
                        const int i = 32 * it + r32, t = t0 + i;
                        const float bs = KIN(I_SBS)[(l * 4 + g) * 128 + i];
                        const bf16_t* ur = P + (size_t)t * NP + PU + g * 128 + 4 * hf;
                        float ss = 0.f;
#pragma unroll
                        for (int ct = 0; ct < 4; ++ct)
#pragma unroll
                            for (int g4 = 0; g4 < 4; ++g4) { const u32x2 uw = *(const u32x2*)(ur + 32 * ct + 8 * g4);
                                const float u0 = bflo(uw.x), u1 = bfhi(uw.x), u2 = bflo(uw.y), u3 = bfhi(uw.y);
                                acc[ct][4 * g4 + 0] = u0 * (acc[ct][4 * g4 + 0] + bs); acc[ct][4 * g4 + 1] = u1 * (acc[ct][4 * g4 + 1] + bs); acc[ct][4 * g4 + 2] = u2 * (acc[ct][4 * g4 + 2] + bs); acc[ct][4 * g4 + 3] = u3 * (acc[ct][4 * g4 + 3] + bs);
                                ss += (acc[ct][4 * g4] * acc[ct][4 * g4] + acc[ct][4 * g4 + 1] * acc[ct][4 * g4 + 1]) + (acc[ct][4 * g4 + 2] * acc[ct][4 * g4 + 2] + acc[ct][4 * g4 + 3] * acc[ct][4 * g4 + 3]); }
                        ss += __shfl_xor(ss, 32);
                        const float rs = __builtin_amdgcn_rsqf(ss * (1.f / 128.f) + EPS);
                        const float* og = KIN(I_SONG) + (l * 4 + g) * 128 + 4 * hf;
                        bf16_t* orow = OMIX + (size_t)t * D + 512 + g * 128 + 4 * hf;
#pragma unroll
                        for (int ct = 0; ct < 4; ++ct)
#pragma unroll
                            for (int g4 = 0; g4 < 4; ++g4) { const f32x4 ov = *(const f32x4*)(og + 32 * ct + 8 * g4);
                                u32x2 o; o.x = cvt_pk_bf16(acc[ct][4 * g4] * rs * ov[0], acc[ct][4 * g4 + 1] * rs * ov[1]); o.y = cvt_pk_bf16(acc[ct][4 * g4 + 2] * rs * ov[2], acc[ct][4 * g4 + 3] * rs * ov[3]);
                                *(u32x2*)(orow + 32 * ct + 8 * g4) = o; }
                    }
                    __syncthreads();
                }
            }
#else
            {
                LAS float* vn = (LAS float*)lds;
                const float* lng = KIN(I_LNG) + l * 512; const float* lnb = KIN(I_LNB) + l * 512;
                for (int unit = bid; unit < 2 * 64 * 4; unit += G) {
                    const int g = unit & 3, blk = (unit >> 2) & 63, b = unit >> 8;
                    const int t0 = b * SEQ + blk * 128;
                    const int row = tid >> 2, part = tid & 3;
                    const bf16_t* pr = P + (size_t)(t0 + row) * NP + PSV;
                    float s = 0.f, s2 = 0.f;
                    for (int c = 0; c < 128; c += 8) { const u32x4 w = *(const u32x4*)(pr + part * 128 + c);
#pragma unroll
                        for (int q = 0; q < 4; ++q) { const float x0 = __builtin_bit_cast(float, w[q] << 16), x1 = __builtin_bit_cast(float, w[q] & 0xffff0000u); s += x0 + x1; s2 += x0 * x0 + x1 * x1; } }
                    s += __shfl_xor(s, 1); s += __shfl_xor(s, 2); s2 += __shfl_xor(s2, 1); s2 += __shfl_xor(s2, 2);
                    const float mean = s * (1.f / 512.f); const float var = fmaxf(s2 * (1.f / 512.f) - mean * mean, 0.f); const float rstd = __builtin_amdgcn_rsqf(var + EPS);
                    for (int c = 0; c < 32; ++c) { const int cc = part * 32 + c; vn[row * 128 + cc] = (bf2f(pr[g * 128 + cc]) - mean) * rstd * lng[g * 128 + cc] + lnb[g * 128 + cc]; }
                    __syncthreads();
                    {
                        const int i = tid >> 2, c0 = (tid & 3) * 32; float a[32];
#pragma unroll
                        for (int q = 0; q < 32; ++q) a[q] = 0.f;
                        const float* wrow = KIN(I_SWS) + ((size_t)(l * 4 + g) * 128 + i) * 128;
                        const int jlim = (i < 64) ? 64 : 128;
                        for (int j = 0; j < jlim; ++j) { const float w = wrow[j];
#pragma unroll
                            for (int q = 0; q < 32; ++q) a[q] += w * vn[j * 128 + c0 + q]; }
                        const float bs = KIN(I_SBS)[(l * 4 + g) * 128 + i];
                        const bf16_t* ur = P + (size_t)(t0 + i) * NP + PU + g * 128 + c0;
                        float ss = 0.f;
#pragma unroll
                        for (int q = 0; q < 32; ++q) { a[q] = bf2f(ur[q]) * (a[q] + bs); ss += a[q] * a[q]; }
                        ss += __shfl_xor(ss, 1); ss += __shfl_xor(ss, 2);
                        const float r = __builtin_amdgcn_rsqf(ss * (1.f / 128.f) + EPS);
                        const float* og = KIN(I_SONG) + (l * 4 + g) * 128 + c0;
                        bf16_t* orow = OMIX + (size_t)(t0 + i) * D + 512 + g * 128 + c0;
#pragma unroll
                        for (int q = 0; q < 32; q += 2) *(unsigned*)(orow + q) = cvt_pk_bf16(a[q] * r * og[q], a[q + 1] * r * og[q + 1]);
                    }
                    __syncthreads();
                }
            }
#endif
        REP_END() }
        SEAM(pb + 1);

        if (IN(pb + 2)) { REP_BEGIN(pb + 2)
            PHASE_BEGIN();
            if (tid < 256) {
                for (int ei = bid * 256 + tid; ei < 65536; ei += G * 256) {
                    const int bh = ei >> 13, rem = ei & 8191, vd = rem >> 6, kd = rem & 63, b = bh >> 2, h = bh & 3;
                    float Sv = 0.f;
                    for (int n = 0; n < 128; n += 8) {
                        float dc[8], kv[8];
#pragma unroll
                        for (int q = 0; q < 8; ++q) { const int cn = b * 128 + n + q; dc[q] = DECAY[(size_t)(cn * 4 + h) * 64 + kd]; kv[q] = KVT[((size_t)(cn * 4 + h) * 128 + vd) * 64 + kd]; }
#pragma unroll
                        for (int q = 0; q < 8; ++q) { const int cn = b * 128 + n + q; ST[((size_t)(cn * 4 + h) * 128 + vd) * 64 + kd] = f2bf(Sv); Sv = dc[q] * Sv + kv[q]; }
                    }
                }
            }
        REP_END() }
        SEAM(pb + 2);

        if (IN(pb + 3)) { REP_BEGIN(pb + 3)
            PHASE_BEGIN();
#if MFMA_G2
            {
                const int r32 = lane & 31, hf = lane >> 5;
                const float* ong = KIN(I_GONG) + l * 128 + 4 * hf;
                for (int task = gw; task < NCH * 4 * 2; task += NGW) {
                    const int unit = task >> 1, rt = task & 1, cn = unit >> 2, hh = unit & 3;
                    const bf16_t* Pc = P + (size_t)(cn * 64) * NP;
                    bf16x8 bq[4];
#pragma unroll
                    for (int ks = 0; ks < 4; ++ks) bq[ks] = *(const bf16x8*)(Pc + (size_t)(32 * rt + r32) * NP + PQ + hh * 64 + 16 * ks + 8 * hf);
                    f32x16 o[4];
#pragma unroll
                    for (int vt = 0; vt < 4; ++vt)
#pragma unroll
                        for (int r = 0; r < 16; ++r) o[vt][r] = 0.f;
                    const bf16_t* vtp = VT + ((size_t)unit * 128 + r32) * 64 + 4 * hf;
                    for (int jt = 0; jt <= rt; ++jt) {
                        f32x16 x;
#pragma unroll
                        for (int r = 0; r < 16; ++r) x[r] = 0.f;
#pragma unroll
                        for (int ks = 0; ks < 4; ++ks) { const bf16x8 ak = *(const bf16x8*)(Pc + (size_t)(32 * jt + r32) * NP + PK + hh * 64 + 16 * ks + 8 * hf); x = MFMA32(ak, bq[ks], x); }
                        if (jt == rt) {
#pragma unroll
                            for (int r = 0; r < 16; ++r) if ((r & 3) + 8 * (r >> 2) + 4 * hf > r32) x[r] = 0.f;
                        }
#pragma unroll
                        for (int s = 0; s < 2; ++s) {
                            const bf16x8 xb = pack8(x[8 * s], x[8 * s + 1], x[8 * s + 2], x[8 * s + 3], x[8 * s + 4], x[8 * s + 5], x[8 * s + 6], x[8 * s + 7]);
#pragma unroll
                            for (int vt = 0; vt < 4; ++vt) {
                                const s16x4 lo = *(const s16x4*)(vtp + (size_t)(32 * vt) * 64 + 32 * jt + 16 * s), hi = *(const s16x4*)(vtp + (size_t)(32 * vt) * 64 + 32 * jt + 16 * s + 8);
                                o[vt] = MFMA32(cat4(lo, hi), xb, o[vt]);
                            }
                        }
                    }
                    const bf16_t* stp = ST + ((size_t)unit * 128 + r32) * 64 + 8 * hf;
#pragma unroll
                    for (int ks = 0; ks < 4; ++ks)
#pragma unroll
                        for (int vt = 0; vt < 4; ++vt) { const bf16x8 as = *(const bf16x8*)(stp + (size_t)(32 * vt) * 64 + 16 * ks); o[vt] = MFMA32(as, bq[ks], o[vt]); }
                    float ss = 0.f;
#pragma unroll
                    for (int vt = 0; vt < 4; ++vt)
#pragma unroll
                        for (int r = 0; r < 16; ++r) ss += o[vt][r] * o[vt][r];
                    ss += __shfl_xor(ss, 32);
                    const float rs = __builtin_amdgcn_rsqf(ss * (1.f / 128.f) + EPS);
                    const int t = cn * 64 + 32 * rt + r32;
                    const bf16_t* ogr = Pc + (size_t)(32 * rt + r32) * NP + POG + hh * 128 + 4 * hf;
                    bf16_t* orow = OMIX + (size_t)t * D + hh * 128 + 4 * hf;
#pragma unroll
                    for (int vt = 0; vt < 4; ++vt)
#pragma unroll
                        for (int g4 = 0; g4 < 4; ++g4) { const u32x2 gw2 = *(const u32x2*)(ogr + 32 * vt + 8 * g4); const f32x4 nv = *(const f32x4*)(ong + 32 * vt + 8 * g4);
                            u32x2 ov; ov.x = cvt_pk_bf16(o[vt][4 * g4] * rs * nv[0] * bflo(gw2.x), o[vt][4 * g4 + 1] * rs * nv[1] * bfhi(gw2.x)); ov.y = cvt_pk_bf16(o[vt][4 * g4 + 2] * rs * nv[2] * bflo(gw2.y), o[vt][4 * g4 + 3] * rs * nv[3] * bfhi(gw2.y));
                            *(u32x2*)(orow + 32 * vt + 8 * g4) = ov; }
                }
            }
#else
            LAS float* qd = (LAS float*)lds;
            LAS float* ki = (LAS float*)(lds + 16640);
            LAS float* vv = (LAS float*)(lds + 33280);
            LAS float* att = (LAS float*)(lds + 66048);
            LAS float* Sm = (LAS float*)(lds + 82688);
            LAS float* segtot = (LAS float*)(lds + 115456);
            const int col = tid & 63, seg = tid >> 6;
            const float* ong = KIN(I_GONG) + l * 128;
            for (int unit = bid; unit < NCH * 4; unit += G) {
                const int cn = unit >> 2, h = unit & 3;
                const bf16_t* Pc = P + (size_t)(cn * 64) * NP;
#pragma unroll
                for (int i = 0; i < 8; ++i) { const size_t ro = (size_t)(seg * 8 + i) * NP; qd[(seg * 8 + i) * 65 + col] = bf2f(Pc[ro + PQ + h * 64 + col]); ki[(seg * 8 + i) * 65 + col] = bf2f(Pc[ro + PK + h * 64 + col]); }
#pragma unroll
                for (int i = 0; i < 16; ++i) { const int idx = tid + 512 * i, p = idx >> 7, vd = idx & 127; vv[p * 128 + vd] = bf2f(Pc[(size_t)p * NP + PV + h * 128 + vd]); }
#pragma unroll
                for (int i = 0; i < 16; ++i) { const int idx = tid + 512 * i, vd = idx >> 6, kd = idx & 63; Sm[kd * 128 + vd] = bf2f(ST[((size_t)(cn * 4 + h) * 128 + vd) * 64 + kd]); }
                __syncthreads();
                {
                    const int i = tid >> 3, j0 = (tid & 7) * 8; float a[8];
#pragma unroll
                    for (int q = 0; q < 8; ++q) a[q] = 0.f;
                    for (int kd = 0; kd < 64; ++kd) { const float x = qd[i * 65 + kd];
#pragma unroll
                        for (int q = 0; q < 8; ++q) a[q] += x * ki[(j0 + q) * 65 + kd]; }
#pragma unroll
                    for (int q = 0; q < 8; ++q) att[i * 65 + j0 + q] = (j0 + q <= i) ? a[q] : 0.f;
                }
                __syncthreads();
                {
                    const int i = tid >> 3, v0 = (tid & 7) * 16; float a[16];
#pragma unroll
                    for (int q = 0; q < 16; ++q) a[q] = 0.f;
                    for (int j = 0; j <= i; ++j) { const float x = att[i * 65 + j];
#pragma unroll
                        for (int q = 0; q < 16; ++q) a[q] += x * vv[j * 128 + v0 + q]; }
                    for (int kd = 0; kd < 64; ++kd) { const float x = qd[i * 65 + kd];
#pragma unroll
                        for (int q = 0; q < 16; ++q) a[q] += x * Sm[kd * 128 + v0 + q]; }
                    float ss = 0.f;
#pragma unroll
                    for (int q = 0; q < 16; ++q) ss += a[q] * a[q];
                    ss += __shfl_xor(ss, 1); ss += __shfl_xor(ss, 2); ss += __shfl_xor(ss, 4);
                    const float r = __builtin_amdgcn_rsqf(ss * (1.f / 128.f) + EPS);
                    const int t = cn * 64 + i;
                    const bf16_t* ogr = P + (size_t)t * NP + POG + h * 128 + v0;
                    bf16_t* orow = OMIX + (size_t)t * D + h * 128 + v0;
#pragma unroll
                    for (int q = 0; q < 16; q += 2) *(unsigned*)(orow + q) = cvt_pk_bf16(a[q] * r * ong[v0 + q] * bf2f(ogr[q]), a[q + 1] * r * ong[v0 + q + 1] * bf2f(ogr[q + 1]));
                }
                __syncthreads();
            }
#endif
        REP_END() }
        SEAM(pb + 3);

        if (IN(pb + 4)) { REP_BEGIN(pb + 4)
            PHASE_BEGIN();
            pg8::DenseSched S; S.init(OMIX, WOUT + (size_t)l * D * D, T, D, G, bid);
            EpiOutProj E{l == 0 ? KIN(I_X) : XOUT, dry ? WSP(float, WS_DRY) : XOUT, modl + 2048};
            pg8::gemm_phase<EpiOutProj, pg8::DenseSched>(lds, tid, D, S, E);
        REP_END() }
        SEAM(pb + 4);

        if (IN(pb + 5)) { REP_BEGIN(pb + 5)
            PHASE_BEGIN();
            const size_t dro = dry ? (WS_DRY - WS_TOK) : 0; bf16_t* Hw = dry ? WSP(bf16_t, WS_DRY + 160 * MiB - 64 * MiB) : H;
            {
                LAS float* slab = (LAS float*)lds;
                LAS float* ssl = (LAS float*)(lds + 65536);
                LAS float* lgt = (LAS float*)(lds + 65536 + 1024);
                LAS float* rl = (LAS float*)(lds + 65536 + 1024 + 5120);
                const int tok = lane & 31, hf = lane >> 5;
                unsigned* cntg = ctl + CW_CNT + l * 32 * 64 + (dry ? 32 : 0);
                LAS unsigned* lcnt = (LAS unsigned*)(lds + 65536 + 1024 + 5120 + 128);
                LAS unsigned* lbase = lcnt + 32;
                if (tid < 32) lcnt[tid] = 0u;
                __syncthreads();
                const bf16_t* wh = WRH + (size_t)l * 64 * D + (size_t)tok * D + 128 * wave + 8 * hf;
                const bf16_t* wl_ = WRL + (size_t)l * 64 * D + (size_t)tok * D + 128 * wave + 8 * hf;
                for (int task = bid; task < T / 32; task += G) {
                    const int t0 = task * 32, b = t0 >= SEQ ? 1 : 0;
                    const float* md = modl + (size_t)b * 6144;
                    const float* xr = XOUT + (size_t)(t0 + tok) * D + 128 * wave + 8 * hf;
                    const float* gp = KIN(I_N2G) + l * D + 128 * wave + 8 * hf;
                    float xs[8][8]; float ssq = 0.f;
                    f32x16 acc[2];
#pragma unroll
                    for (int nt = 0; nt < 2; ++nt)
#pragma unroll
                        for (int r = 0; r < 16; ++r) acc[nt][r] = 0.f;
#pragma unroll
                    for (int ks = 0; ks < 8; ++ks) {
                        const f32x4 x0 = *(const f32x4*)(xr + 16 * ks), x1 = *(const f32x4*)(xr + 16 * ks + 4);
                        const f32x4 g0 = *(const f32x4*)(gp + 16 * ks), g1 = *(const f32x4*)(gp + 16 * ks + 4);
                        const f32x4 c0 = *(const f32x4*)(md + 4096 + 128 * wave + 8 * hf + 16 * ks), c1 = *(const f32x4*)(md + 4096 + 128 * wave + 8 * hf + 16 * ks + 4);
                        ssq += (x0[0] * x0[0] + x0[1] * x0[1]) + (x0[2] * x0[2] + x0[3] * x0[3]) + (x1[0] * x1[0] + x1[1] * x1[1]) + (x1[2] * x1[2] + x1[3] * x1[3]);
#pragma unroll
                        for (int j = 0; j < 4; ++j) { xs[ks][j] = x0[j] * g0[j] * (c0[j] + 1.f); xs[ks][4 + j] = x1[j] * g1[j] * (c1[j] + 1.f); }
                        const bf16x8 ah = pack8(xs[ks][0], xs[ks][1], xs[ks][2], xs[ks][3], xs[ks][4], xs[ks][5], xs[ks][6], xs[ks][7]);
                        const u32x4 ahw = __builtin_bit_cast(u32x4, ah);
                        const bf16x8 al = pack8(xs[ks][0] - bflo(ahw[0]), xs[ks][1] - bfhi(ahw[0]), xs[ks][2] - bflo(ahw[1]), xs[ks][3] - bfhi(ahw[1]),
                                                xs[ks][4] - bflo(ahw[2]), xs[ks][5] - bfhi(ahw[2]), xs[ks][6] - bflo(ahw[3]), xs[ks][7] - bfhi(ahw[3]));
#pragma unroll
                        for (int nt = 0; nt < 2; ++nt) {
                            const bf16x8 bh = *(const bf16x8*)(wh + (size_t)(32 * nt) * D + 16 * ks), bl = *(const bf16x8*)(wl_ + (size_t)(32 * nt) * D + 16 * ks);
                            acc[nt] = MFMA32(ah, bh, acc[nt]); acc[nt] = MFMA32(al, bh, acc[nt]); acc[nt] = MFMA32(ah, bl, acc[nt]);
                        }
                    }
                    ssq += __shfl_xor(ssq, 32);
                    if (hf == 0) ssl[wave * 32 + tok] = ssq;
#pragma unroll
                    for (int nt = 0; nt < 2; ++nt)
#pragma unroll
                        for (int r = 0; r < 16; ++r) slab[(wave * 32 + (r & 3) + 8 * (r >> 2) + 4 * hf) * 64 + 32 * nt + tok] = acc[nt][r];
                    __syncthreads();
                    {
                        const int tk = tid >> 4, sub = tid & 15;
                        float s8 = 0.f;
#pragma unroll
                        for (int w = 0; w < 8; ++w) s8 += ssl[w * 32 + tk];
                        const float r = __builtin_amdgcn_rsqf(s8 * (1.f / D) + EPS);
                        if (sub == 0) rl[tk] = r;
#pragma unroll
                        for (int q = 0; q < 3; ++q) { const int e = sub + 16 * q;
                            if (e < 36) { float a = 0.f;
#pragma unroll
                                for (int w = 0; w < 8; ++w) a += slab[(w * 32 + tk) * 64 + e];
                                lgt[tk * 40 + e] = r * a + SHW[(l * 2 + b) * 64 + e]; } }
                    }
                    __syncthreads();
                    int e1 = 0, e2 = 0, li1 = 0, li2 = 0; float w1 = 0.f, w2 = 0.f;
                    if (tid < 32) {
                        const LAS float* lg = lgt + tid * 40;
                        int gi = 0; float gm = lg[32];
#pragma unroll
                        for (int q = 1; q < 4; ++q) { const float v = lg[32 + q]; if (v > gm) { gm = v; gi = q; } }
                        float den = 0.f;
#pragma unroll
                        for (int q = 0; q < 4; ++q) den += __expf(lg[32 + q] - gm);
                        const float gwt = 1.f / den;
                        float el[8];
#pragma unroll
                        for (int q = 0; q < 8; ++q) el[q] = lg[gi * 8 + q];
                        int i1 = 0; float v1 = el[0];
#pragma unroll
                        for (int q = 1; q < 8; ++q) if (el[q] > v1) { v1 = el[q]; i1 = q; }
                        int i2 = -1; float v2 = -3.0e38f;
#pragma unroll
                        for (int q = 0; q < 8; ++q) if (q != i1 && el[q] > v2) { v2 = el[q]; i2 = q; }
                        const float ex = __expf(v2 - v1); w1 = gwt / (1.f + ex); w2 = gwt * ex / (1.f + ex);
                        e1 = gi * 8 + i1; e2 = gi * 8 + i2;
                        li1 = (int)atomicAdd((unsigned*)(lcnt + e1), 1u); li2 = (int)atomicAdd((unsigned*)(lcnt + e2), 1u);
                    }
                    __syncthreads();
                    if (tid < 32) { const unsigned n = lcnt[tid]; lbase[tid] = n ? atomicAdd(cntg + tid * 64, n) : 0u; lcnt[tid] = 0u; }
                    __syncthreads();
                    if (tid < 32) {
                        const int t = t0 + tid, s1 = (int)lbase[e1] + li1, s2 = (int)lbase[e2] + li2;
                        int* tokw = (int*)((char*)TOK + dro); float* wlw = (float*)((char*)WL + dro); int* refw = (int*)((char*)REF + dro);
                        tokw[(size_t)e1 * T + s1] = t; wlw[(size_t)e1 * T + s1] = w1; tokw[(size_t)e2 * T + s2] = t; wlw[(size_t)e2 * T + s2] = w2;
                        refw[2 * t] = (e1 << 16) | s1; refw[2 * t + 1] = (e2 << 16) | s2;
                    }
                    {
                        const float r = rl[tok];
                        bf16_t* hr = Hw + (size_t)(t0 + tok) * D + 128 * wave + 8 * hf;
#pragma unroll
                        for (int ks = 0; ks < 8; ++ks) { const f32x4 s0 = *(const f32x4*)(md + 3072 + 128 * wave + 8 * hf + 16 * ks), s1 = *(const f32x4*)(md + 3072 + 128 * wave + 8 * hf + 16 * ks + 4);
                            *(bf16x8*)(hr + 16 * ks) = pack8(r * xs[ks][0] + s0[0], r * xs[ks][1] + s0[1], r * xs[ks][2] + s0[2], r * xs[ks][3] + s0[3], r * xs[ks][4] + s1[0], r * xs[ks][5] + s1[1], r * xs[ks][6] + s1[2], r * xs[ks][7] + s1[3]); }
                    }
                    __syncthreads();
                }
            }
        REP_END() }
        SEAM(pb + 5);

#define MOE_TABLES(NSUB) do { __syncthreads(); if (tid < 32) TB_CNT[tid] = (int)__hip_atomic_load(ctl + CW_CNT + (l * 32 + tid) * 64, __ATOMIC_RELAXED, __HIP_MEMORY_SCOPE_AGENT); __syncthreads(); \
        if (tid == 0) { int _tp = 0, _bs = 0; for (int _e = 0; _e < 32; ++_e) { TB_TP[_e] = _tp; TB_BASE[_e] = _bs; _tp += (TB_CNT[_e] + 255) >> 8; _bs += TB_CNT[_e]; } TB_TP[32] = _tp; TB_BASE[32] = _bs; } __syncthreads(); \
        if (tid < 16) { const int _L = tid * G + bid, _tile = _L / (NSUB); int _e = -1; if (_tile < TB_TP[32]) { _e = 0; for (int _j = 1; _j < 32; ++_j) _e += (TB_TP[_j] <= _tile) ? 1 : 0; } TB_UE[tid] = _e; } __syncthreads(); } while (0)

        if (IN(pb + 6)) { REP_BEGIN(pb + 6)
            PHASE_BEGIN();
            MOE_TABLES(2);
            MoeSched1 S{{TB_TP, TB_CNT, TB_BASE, TB_UE}, (const char*)H, (const char*)(WGU + (size_t)l * 32 * 512 * D), TOK, G, bid};
            EpiMoe1 E{ACT, WL};
            pg8::gemm_phase<EpiMoe1, MoeSched1>(lds, tid, D, S, E);
        REP_END() }
        SEAM(pb + 6);

        if (IN(pb + 7)) { REP_BEGIN(pb + 7)
            PHASE_BEGIN();
            MOE_TABLES(4);
            MoeSched2 S{{TB_TP, TB_CNT, TB_BASE, TB_UE}, (const char*)ACT, (const char*)(WD + (size_t)l * 32 * D * 256), nullptr, G, bid};
            EpiMoe2 E{Y};
            pg8::gemm_phase<EpiMoe2, MoeSched2>(lds, tid, 256, S, E);
        REP_END() }
        SEAM(pb + 7);

        if (IN(pb + 8)) { REP_BEGIN(pb + 8)
            PHASE_BEGIN();
            MOE_TABLES(1);
            for (int t = gw; t < T; t += NGW) {
                const int b = t >= SEQ ? 1 : 0;
                const int r1 = REF[2 * t], r2 = REF[2 * t + 1];
                const bf16_t* y1 = Y + (size_t)(TB_BASE[r1 >> 16] + (r1 & 0xffff)) * D; const bf16_t* y2 = Y + (size_t)(TB_BASE[r2 >> 16] + (r2 & 0xffff)) * D;
                const float* gt = modl + (size_t)b * 6144 + 5120;
                float* xr = XOUT + (size_t)t * D; float* xw = dry ? WSP(float, WS_DRY) + (size_t)t * D : xr; bf16_t* Hw = dry ? WSP(bf16_t, WS_DRY + 96 * MiB) : H;
                f32x4 v[4]; float s = 0.f;
#pragma unroll
                for (int j = 0; j < 4; ++j) {
                    const f32x4 xo = *((const f32x4*)xr + lane + 64 * j), gg = *((const f32x4*)gt + lane + 64 * j);
                    const u32x2 a = *((const u32x2*)y1 + lane + 64 * j), c = *((const u32x2*)y2 + lane + 64 * j);
                    f32x4 m; m.x = __builtin_bit_cast(float, a.x << 16) + __builtin_bit_cast(float, c.x << 16); m.y = __builtin_bit_cast(float, a.x & 0xffff0000u) + __builtin_bit_cast(float, c.x & 0xffff0000u);
                    m.z = __builtin_bit_cast(float, a.y << 16) + __builtin_bit_cast(float, c.y << 16); m.w = __builtin_bit_cast(float, a.y & 0xffff0000u) + __builtin_bit_cast(float, c.y & 0xffff0000u);
                    v[j] = xo + gg * m; s += (v[j].x * v[j].x + v[j].y * v[j].y) + (v[j].z * v[j].z + v[j].w * v[j].w);
                }
                const float r = __builtin_amdgcn_rsqf(wave_sum(s) * (1.f / D) + EPS);
                if (l + 1 < DEPTH) {
                    const float* md = MOD + (size_t)((l + 1) * 2 + b) * 6144; const float* gp = KIN(I_N1G) + (l + 1) * D;
#pragma unroll
                    for (int j = 0; j < 4; ++j) { *((f32x4*)xw + lane + 64 * j) = v[j];
                        const f32x4 g = *((const f32x4*)gp + lane + 64 * j), sc = *((const f32x4*)(md + 1024) + lane + 64 * j), sh = *((const f32x4*)md + lane + 64 * j);
                        const f32x4 hh = (v[j] * r) * g * (sc + 1.f) + sh; u32x2 o; o.x = cvt_pk_bf16(hh.x, hh.y); o.y = cvt_pk_bf16(hh.z, hh.w); *((u32x2*)(Hw + (size_t)t * D) + lane + 64 * j) = o; }
                } else {
#pragma unroll
                    for (int j = 0; j < 4; ++j) { const f32x4 g = *((const f32x4*)KIN(I_FING) + lane + 64 * j); *((f32x4*)xw + lane + 64 * j) = (v[j] * r) * g; }
                }
            }
        REP_END() }
        SEAM(pb + 8);
    }
#undef IN
#undef SEAM
}

extern "C" void kernel_launch(void* const* d_in, const int* in_sizes, int n_in, void* d_out, int out_size, void* d_ws, size_t ws_size, hipStream_t stream) {
    static int grid = 0;
    if (grid == 0) {
        if (n_in != 24 || out_size != T * D || ws_size < WS_END) { fprintf(stderr, "kernel_launch: unexpected shapes (n_in %d, out %d, ws %zu)\n", n_in, out_size, ws_size); grid = -1; return; }
        int dev = 0, cus = 0, per_cu = 0;
        if (hipGetDevice(&dev) != hipSuccess || hipDeviceGetAttribute(&cus, hipDeviceAttributeMultiprocessorCount, dev) != hipSuccess) { grid = -1; return; }
        if (hipFuncSetAttribute((const void*)fwd_kernel, hipFuncAttributeMaxDynamicSharedMemorySize, LDS_BYTES) != hipSuccess) { fprintf(stderr, "kernel_launch: hipFuncSetAttribute failed\n"); grid = -1; return; }
        if (hipOccupancyMaxActiveBlocksPerMultiprocessor(&per_cu, (const void*)fwd_kernel, NWAVES * 64, LDS_BYTES) != hipSuccess || per_cu < 1) { fprintf(stderr, "kernel_launch: occupancy query says %d\n", per_cu); }
        (void)hipGetLastError();
        grid = cus;
    }
    if (grid < 0) return;
    if (hipMemsetAsync((char*)d_ws + WS_CTL, 0, CTL_ZERO_BYTES, stream) != hipSuccess) return;
    Args a{};
    for (int i = 0; i < 24; ++i) a.in[i] = (const float*)d_in[i];
    a.out = (float*)d_out; a.ws = (unsigned char*)d_ws;
#if MK_SPLIT
    for (int p = 0; p < NPH; ++p) { a.ph_lo = p; a.ph_hi = p + 1; hipLaunchKernelGGL(fwd_kernel, dim3(grid), dim3(NWAVES * 64), LDS_BYTES, stream, a); }
#else
    a.ph_lo = 0; a.ph_hi = NPH;
    hipLaunchKernelGGL(fwd_kernel, dim3(grid), dim3(NWAVES * 64), LDS_BYTES, stream, a);
#endif
}
```

```cpp
#include <hip/hip_runtime.h>
#include <cstdio>
#include <cstdint>

#ifndef MK_SPLIT
#define MK_SPLIT 0
#endif
#ifndef MFMA_SGU
#define MFMA_SGU 1
#endif
#ifndef MFMA_G1
#define MFMA_G1 1
#endif
#ifndef MFMA_G2
#define MFMA_G2 1
#endif

#define LAS __attribute__((address_space(3)))
#define CAS __attribute__((address_space(4)))
#define GAS __attribute__((address_space(1)))
typedef unsigned short bf16_t;
typedef short bf16x8 __attribute__((ext_vector_type(8)));
typedef float f32x4 __attribute__((ext_vector_type(4)));
typedef float f32x2 __attribute__((ext_vector_type(2)));
typedef unsigned u32x4 __attribute__((ext_vector_type(4)));
typedef unsigned u32x2 __attribute__((ext_vector_type(2)));

constexpr int D = 1024, SEQ = 8192, T = 16384, DEPTH = 4, NWAVES = 8;
constexpr int INC = 2576;
constexpr int NP = 2816;
constexpr int PQ = 0, PK = 256, PG = 512, PV = 768, POG = 1280, PU = 1792, PSV = 2304;
constexpr int NCH = 256;
constexpr float EPS = 1e-6f;
constexpr int NPH = 2 + 9 * DEPTH;

constexpr size_t MiB = 1u << 20;
constexpr size_t WS_CTL = 0, CTL_ZERO_BYTES = 1 * MiB;
constexpr size_t WS_MOD = 1 * MiB;
constexpr size_t WS_WRH = 2 * MiB;
constexpr size_t WS_WRL = 2 * MiB + 512 * 1024;
constexpr size_t WS_SHW = 1 * MiB + 256 * 1024;
constexpr size_t WS_TOK = 3 * MiB;
constexpr size_t WS_WL = 5 * MiB;
constexpr size_t WS_REF = 7 * MiB;
constexpr size_t WS_DECAY = 8 * MiB;
constexpr size_t WS_WIN = 10 * MiB;
constexpr size_t WS_WOUT = 32 * MiB;
constexpr size_t WS_WGU = 40 * MiB;
constexpr size_t WS_WD = 168 * MiB;
constexpr size_t WS_H = 232 * MiB;
constexpr size_t WS_P = 264 * MiB;
constexpr size_t WS_Y = 264 * MiB;
constexpr size_t WS_KVT = 352 * MiB;
constexpr size_t WS_ACT = 352 * MiB;
constexpr size_t WS_ST = 384 * MiB;
constexpr size_t WS_OMIX = 400 * MiB;
constexpr size_t WS_VT = 432 * MiB;
constexpr size_t WS_END = 448 * MiB;
constexpr size_t WS_DRY = 448 * MiB;
constexpr int CW_BAR = 4096;
constexpr int CW_CNT = 16384;

constexpr int RING_BYTES = 131072;
constexpr int MISC_OFF = RING_BYTES;
constexpr int LDS_BYTES = 147456;

__device__ __forceinline__ float bf2f(bf16_t v) { return __builtin_bit_cast(float, (unsigned)v << 16); }
typedef __bf16 bf16x2_t __attribute__((ext_vector_type(2)));
__device__ __forceinline__ unsigned cvt_pk_bf16(float lo, float hi) { const f32x2 v = {lo, hi}; const bf16x2_t b = __builtin_convertvector(v, bf16x2_t); return __builtin_bit_cast(unsigned, b); }
typedef short s16x4 __attribute__((ext_vector_type(4)));
typedef _Float16 f16x8 __attribute__((ext_vector_type(8)));
typedef _Float16 f16x2 __attribute__((ext_vector_type(2)));
__device__ __forceinline__ unsigned cvt_pk_f16(float lo, float hi) { return __builtin_bit_cast(unsigned, __builtin_amdgcn_cvt_pkrtz(lo, hi)); }
__device__ __forceinline__ float h16lo(unsigned w) { const f16x2 v = __builtin_bit_cast(f16x2, w); return (float)v[0]; }
__device__ __forceinline__ float h16hi(unsigned w) { const f16x2 v = __builtin_bit_cast(f16x2, w); return (float)v[1]; }
typedef short v4i16_t __attribute__((ext_vector_type(4)));
typedef float f32x16 __attribute__((ext_vector_type(16)));
__device__ __forceinline__ s16x4 lds_tr(const LAS unsigned char* p) { return __builtin_bit_cast(s16x4, __builtin_amdgcn_ds_read_tr16_b64_v4i16((LAS v4i16_t*)p)); }
#define MFMA32(a, b, c) __builtin_amdgcn_mfma_f32_32x32x16_bf16((a), (b), (c), 0, 0, 0)
__device__ __forceinline__ bf16x8 cat4(s16x4 lo, s16x4 hi) { return __builtin_shufflevector(lo, hi, 0, 1, 2, 3, 4, 5, 6, 7); }
__device__ __forceinline__ bf16x8 pack8(float a0, float a1, float a2, float a3, float a4, float a5, float a6, float a7) {
    u32x4 w; w.x = cvt_pk_bf16(a0, a1); w.y = cvt_pk_bf16(a2, a3); w.z = cvt_pk_bf16(a4, a5); w.w = cvt_pk_bf16(a6, a7); return __builtin_bit_cast(bf16x8, w); }
__device__ __forceinline__ float bflo(unsigned w) { return __builtin_bit_cast(float, w << 16); }
__device__ __forceinline__ float bfhi(unsigned w) { return __builtin_bit_cast(float, w & 0xffff0000u); }
__device__ __forceinline__ bf16_t f2bf(float f) { return (bf16_t)(cvt_pk_bf16(f, 0.f) & 0xffffu); }
__device__ __forceinline__ float wave_sum(float v) {
#pragma unroll
    for (int o = 1; o < 64; o <<= 1) v += __shfl_xor(v, o);
    return v;
}
__device__ __forceinline__ float silu_f(float x) { return x * __builtin_amdgcn_rcpf(1.f + __expf(-x)); }
__device__ __forceinline__ float gelu_tanh_f(float x) { const float u = 0.7978845608028654f * (x + 0.044715f * x * x * x); return x * __builtin_amdgcn_rcpf(1.f + __expf(-2.f * u)); }
__device__ __forceinline__ float logsig_f(float z) { return fminf(z, 0.f) - __logf(1.f + __expf(-fabsf(z))); }
#define LDS_WAIT() asm volatile("s_waitcnt lgkmcnt(0)" ::: "memory")
__device__ __forceinline__ const char* uni_ptr(const char* p) {
    unsigned long long v = (unsigned long long)p; unsigned lo = __builtin_amdgcn_readfirstlane((unsigned)v), hi = __builtin_amdgcn_readfirstlane((unsigned)(v >> 32));
    return (const char*)(((unsigned long long)hi << 32) | lo);
}

namespace pg8 {
constexpr int BM = 256, BK = 64, HALF = 128, HTB = HALF * BK * 2, STAGE_BYTES = 8 * HTB, NXCD = 8, WGM = 8;
__host__ __device__ __forceinline__ int lds_byte(int r, int c) { const int st = (r >> 4) * 2 + (c >> 5), rr = r & 15, cc = c & 31, ob = rr * 64 + cc * 2; return st * 1024 + (ob ^ (((ob >> 9) & 1) << 5)); }
__host__ __device__ __forceinline__ void stage_rc(int b, int& R, int& C) { const int st = b / 1024, sb = b % 1024, swz = sb ^ (((sb >> 9) & 1) << 5); R = (st >> 1) * 16 + swz / 64; C = (st & 1) * 32 + (swz % 64) / 2; }
__host__ __device__ __forceinline__ int perm32(int rho) { const int n = rho >> 4, i = rho & 15; return 8 * (i >> 2) + 4 * n + (i & 3); }

struct Unit { int arow, brow, row0, col0, nvalid, toff; };

struct DenseSched {
    static constexpr bool GATHER = false, PARTIAL = false;
    const char* A; const char* B; const int* tok; int nM, nN, nwg, G, c;
    __device__ void init(const void* A_, const void* Bt_, int M, int N, int G_, int c_) { A = (const char*)A_; B = (const char*)Bt_; tok = nullptr; nM = M / BM; nN = N / BM; nwg = nM * nN; G = G_; c = c_; }
    __device__ __forceinline__ bool next(int i, Unit& u) const {
        const long L = (long)i * G + c; if (L >= nwg) return false;
        int wgid = (int)L; { const int q = nwg / NXCD, r = nwg % NXCD, xcd = wgid % NXCD, off = wgid / NXCD; wgid = (xcd < r ? xcd * (q + 1) : r * (q + 1) + (xcd - r) * q) + off; }
        const int nig = WGM * nN, gid = wgid / nig, fm = gid * WGM, gsz = (nM - fm) < WGM ? (nM - fm) : WGM;
        const int pm = fm + ((wgid % nig) % gsz), pn = (wgid % nig) / gsz;
        u.arow = pm * BM; u.brow = pn * BM; u.row0 = pm * BM; u.col0 = pn * BM; u.nvalid = BM; u.toff = 0; return true;
    }
};

template <class Epi, class Sched>
__device__ __forceinline__ void gemm_phase(LAS unsigned char* lds, const int tid, const int K, const Sched& S, const Epi& E) {
    const int wid = __builtin_amdgcn_readfirstlane(tid >> 6), lane = tid & 63, wr = wid >> 2, wc = wid & 3, fr = lane & 15, fq = lane >> 4;
    const int nt = K / BK;
    int stR[2], stC[2]; unsigned voffB[2];
#pragma unroll
    for (int i = 0; i < 2; ++i) { int R, C; stage_rc(tid * 16 + i * 8192, R, C); stR[i] = R; stC[i] = C; const int Rb = Epi::PERM ? ((R & ~31) + perm32(R & 31)) : R; voffB[i] = (unsigned)(Rb * K + C) * 2u; }
    const size_t kstep = (size_t)(BK * 2);
    const size_t hstep = (size_t)HALF * K * 2;
    const unsigned ldsw = (unsigned)wid * 1024u;
    const int aoff = lds_byte(wr * 64 + fr, fq * 8), boff = lds_byte(wc * 32 + fr, fq * 8);
#define PG8_SA(b, h) (((b) * 2 + (h)) * HTB)
#define PG8_SB(b, h) ((4 + (b) * 2 + (h)) * HTB)
#define PG8_STAGE(bufoff, gbase, voff) do { _Pragma("unroll") for (int _i = 0; _i < 2; ++_i) \
        __builtin_amdgcn_global_load_lds((const unsigned*)((const char*)(gbase) + (voff)[_i]), (LAS unsigned*)(lds + (bufoff) + ldsw + _i * 8192), 16, 0, 0); } while (0)
#define PG8_LDA(dst, b, h) do { _Pragma("unroll") for (int m = 0; m < 4; ++m) _Pragma("unroll") for (int k = 0; k < 2; ++k) dst[m][k] = *(const LAS bf16x8*)(lds + PG8_SA(b, h) + aoff + m * 2048 + k * 1024); } while (0)
#define PG8_LDB(dst, b, h) do { _Pragma("unroll") for (int n = 0; n < 2; ++n) _Pragma("unroll") for (int k = 0; k < 2; ++k) dst[n][k] = *(const LAS bf16x8*)(lds + PG8_SB(b, h) + boff + n * 2048 + k * 1024); } while (0)
#define PG8_MMA(ai, bj, At, Bt) do { __builtin_amdgcn_s_setprio(1); _Pragma("unroll") for (int m = 0; m < 4; ++m) _Pragma("unroll") for (int n = 0; n < 2; ++n) _Pragma("unroll") for (int k = 0; k < 2; ++k) \
        acc[ai][bj][m][n] = __builtin_amdgcn_mfma_f32_16x16x32_bf16(Bt[n][k], At[m][k], acc[ai][bj][m][n], 0, 0, 0); __builtin_amdgcn_s_setprio(0); } while (0)
#define PG8_WAIT_V(n) asm volatile("s_waitcnt vmcnt(" #n ")" ::: "memory")
#define PG8_WAIT_L(n) asm volatile("s_waitcnt lgkmcnt(" #n ")" ::: "memory")
#define PG8_BAR __builtin_amdgcn_s_barrier()
#define PG8_SCHED __builtin_amdgcn_sched_barrier(0)
#define PG8_MKVA(u, v) do { _Pragma("unroll") for (int _h = 0; _h < 2; ++_h) _Pragma("unroll") for (int _i = 0; _i < 2; ++_i) { \
        if constexpr (Sched::GATHER) { const int _idx = _h * HALF + stR[_i]; const int _tk = (_idx < (u).nvalid) ? S.tok[(u).toff + _idx] : 0; (v)[_h][_i] = (unsigned)_tk * (unsigned)(K * 2) + (unsigned)(stC[_i] * 2); } \
        else (v)[_h][_i] = (unsigned)(_h * (int)hstep) + (unsigned)(stR[_i] * K + stC[_i]) * 2u; } } while (0)
    Unit cur, nxt; int ui = 0;
    if (!S.next(0, cur)) return;
    f32x4 acc[2][2][4][2];
#pragma unroll
    for (int a = 0; a < 2; ++a)
#pragma unroll
        for (int b = 0; b < 2; ++b)
#pragma unroll
            for (int m = 0; m < 4; ++m)
#pragma unroll
                for (int n = 0; n < 2; ++n) acc[a][b][m][n] = (f32x4){0.f, 0.f, 0.f, 0.f};
    bf16x8 At[4][2], B0[2][2], B1[2][2];
    unsigned vAc[2][2], vAn[2][2];
    PG8_MKVA(cur, vAc);
#define PG8_UA(u) (Sched::GATHER ? S.A : S.A + (size_t)(u).arow * (size_t)(K * 2))
#define PG8_UB(u) (S.B + (size_t)(u).brow * (size_t)(K * 2))
    const char* cA = uni_ptr(PG8_UA(cur)); const char* cB = uni_ptr(PG8_UB(cur));
    PG8_STAGE(PG8_SB(0, 0), cB, voffB); PG8_STAGE(PG8_SB(0, 1), cB + hstep, voffB); PG8_STAGE(PG8_SA(0, 0), cA, vAc[0]); PG8_STAGE(PG8_SA(0, 1), cA, vAc[1]);
    if (wr == 1) PG8_BAR;
    PG8_WAIT_V(2); PG8_BAR;
    PG8_STAGE(PG8_SB(1, 0), cB + kstep, voffB); PG8_STAGE(PG8_SA(1, 0), cA + kstep, vAc[0]); PG8_STAGE(PG8_SB(1, 1), cB + hstep + kstep, voffB);
    PG8_WAIT_V(6); PG8_BAR;
    for (;;) {
        const bool has_next = S.next(ui + 1, nxt);
        if (has_next) { PG8_MKVA(nxt, vAn); }
        else {
#pragma unroll
            for (int h = 0; h < 2; ++h)
#pragma unroll
                for (int i = 0; i < 2; ++i) vAn[h][i] = vAc[h][i];
        }
        const char* nA = has_next ? uni_ptr(PG8_UA(nxt)) : cA; const char* nB = has_next ? uni_ptr(PG8_UB(nxt)) : cB;
#pragma nounroll
        for (int t = 0; t < nt; t += 2) {
            const bool last = (t == nt - 2);
            const char* a1 = cA + (size_t)(t + 1) * kstep;
            const char* a2 = last ? nA : cA + (size_t)(t + 2) * kstep; const char* b2 = last ? nB : cB + (size_t)(t + 2) * kstep;
            const char* a3 = a2 + kstep; const char* b3 = b2 + kstep;
            unsigned v2[2][2];
#pragma unroll
            for (int h = 0; h < 2; ++h)
#pragma unroll
                for (int i = 0; i < 2; ++i) v2[h][i] = last ? vAn[h][i] : vAc[h][i];
            const bool do0 = !Sched::PARTIAL || (wr * 64 < cur.nvalid), do1 = !Sched::PARTIAL || (HALF + wr * 64 < cur.nvalid);
            PG8_LDB(B0, 0, 0); PG8_LDB(B1, 0, 1); PG8_SCHED; PG8_LDA(At, 0, 0); PG8_STAGE(PG8_SA(1, 1), a1, vAc[1]);
            PG8_WAIT_V(8); PG8_WAIT_L(0); PG8_BAR; if (do0) { PG8_MMA(0, 0, At, B0); PG8_MMA(0, 1, At, B1); } PG8_BAR; PG8_SCHED;
            PG8_LDA(At, 0, 1); PG8_STAGE(PG8_SB(0, 0), b2, voffB); PG8_STAGE(PG8_SB(0, 1), b2 + hstep, voffB); PG8_STAGE(PG8_SA(0, 0), a2, v2[0]);
            PG8_WAIT_V(8); PG8_WAIT_L(0); PG8_BAR; if (do1) { PG8_MMA(1, 0, At, B0); PG8_MMA(1, 1, At, B1); } PG8_BAR; PG8_SCHED;
            PG8_LDB(B0, 1, 0); PG8_LDB(B1, 1, 1); PG8_SCHED; PG8_LDA(At, 1, 0); PG8_STAGE(PG8_SA(0, 1), a2, v2[1]);
            PG8_WAIT_V(8); PG8_WAIT_L(0); PG8_BAR; if (do0) { PG8_MMA(0, 0, At, B0); PG8_MMA(0, 1, At, B1); } PG8_BAR; PG8_SCHED;
            PG8_LDA(At, 1, 1); PG8_STAGE(PG8_SB(1, 0), b3, voffB); PG8_STAGE(PG8_SB(1, 1), b3 + hstep, voffB); PG8_STAGE(PG8_SA(1, 0), a3, v2[0]);
            PG8_WAIT_V(8); PG8_WAIT_L(0); PG8_BAR; if (do1) { PG8_MMA(1, 0, At, B0); PG8_MMA(1, 1, At, B1); } PG8_BAR; PG8_SCHED;
        }
        if (wr == 0) PG8_BAR;
        E(acc, cur, wr, wc, fr, fq);
        if (!has_next) break;
#pragma unroll
        for (int a = 0; a < 2; ++a)
#pragma unroll
            for (int b = 0; b < 2; ++b)
#pragma unroll
                for (int m = 0; m < 4; ++m)
#pragma unroll
                    for (int n = 0; n < 2; ++n) acc[a][b][m][n] = (f32x4){0.f, 0.f, 0.f, 0.f};
        cur = nxt; cA = nA; cB = nB; ++ui;
#pragma unroll
        for (int h = 0; h < 2; ++h)
#pragma unroll
            for (int i = 0; i < 2; ++i) vAc[h][i] = vAn[h][i];
        if (wr == 1) PG8_BAR;
    }
    PG8_WAIT_V(0);
    PG8_BAR;
#undef PG8_SA
#undef PG8_SB
#undef PG8_STAGE
#undef PG8_LDA
#undef PG8_LDB
#undef PG8_MMA
#undef PG8_WAIT_V
#undef PG8_WAIT_L
#undef PG8_BAR
#undef PG8_SCHED
#undef PG8_MKVA
#undef PG8_UA
#undef PG8_UB
}
}

#define XB_TMO      128
#define XB_XCNT(j)  (256  + 64 * (j))
#define XB_XSUB(j)  (1280 + 64 * (j))
#define XB_XGEN(j)  (2304 + 64 * (j))
#define XB_TOP      3328
#define XB_TOPGEN   3392
#define XCD_BAR_WORDS 3456
#define XB_SPIN_CAP (1u << 18)
__device__ __forceinline__ unsigned xb_ld(unsigned* p)              { return __hip_atomic_load(p, __ATOMIC_RELAXED, __HIP_MEMORY_SCOPE_AGENT); }
__device__ __forceinline__ unsigned xb_add(unsigned* p, unsigned v) { return __hip_atomic_fetch_add(p, v, __ATOMIC_RELAXED, __HIP_MEMORY_SCOPE_AGENT); }
__device__ __forceinline__ unsigned xb_xcc_id() { return (unsigned)__builtin_amdgcn_s_getreg((3 << 11) | 20) & 0xFu; }
#define XB_SPIN(cond, bar) do { unsigned _sp = 0; while (cond) { __builtin_amdgcn_s_sleep(1); \
    if ((++_sp & 255u) == 0u) { if (xb_ld(&(bar)[XB_TMO])) break; if (_sp > XB_SPIN_CAP) { atomicAdd(&(bar)[XB_TMO], 1u); break; } } } } while (0)
struct XcdBarrier { unsigned* bar; unsigned x; volatile LAS unsigned* st; };
__device__ __forceinline__ XcdBarrier xcd_barrier_post(unsigned* bar, volatile LAS unsigned* st) {
    XcdBarrier b; b.bar = bar; b.x = xb_xcc_id(); b.st = st;
    if (threadIdx.x == 0) (void)xb_add(&bar[XB_XCNT(b.x)], 1u);
    return b;
}
__device__ __forceinline__ void xcd_barrier_complete(unsigned* bar, unsigned x, unsigned& nloc, unsigned& nx) {
    const unsigned G = gridDim.x * gridDim.y * gridDim.z;
    unsigned sum, cnt, mine, sp = 0u;
    for (;;) {
        sum = 0u; cnt = 0u; mine = 0u;
#pragma unroll
        for (unsigned j = 0; j < 16; ++j) { const unsigned c = xb_ld(&bar[XB_XCNT(j)]); sum += c; cnt += (c > 0u) ? 1u : 0u; mine = (j == x) ? c : mine; }
        if (sum == G) break;
        __builtin_amdgcn_s_sleep(1);
        if ((++sp & 255u) == 0u) { if (xb_ld(&bar[XB_TMO])) break; if (sp > XB_SPIN_CAP) { atomicAdd(&bar[XB_TMO], 1u); break; } }
    }
    nloc = mine > 0u ? mine : 1u; nx = cnt > 0u ? cnt : 1u;
}
__device__ __forceinline__ void xcd_barrier(const XcdBarrier& b) {
    asm volatile("s_waitcnt vmcnt(0)" ::: "memory");
    __syncthreads();
    if (threadIdx.x == 0) {
        unsigned* bar = b.bar;
        __builtin_amdgcn_s_waitcnt(0);
        unsigned nloc = b.st[0], nx = b.st[1];
        if (nloc == 0u) { xcd_barrier_complete(bar, b.x, nloc, nx); b.st[0] = nloc; b.st[1] = nx; }
        const unsigned old = xb_add(&bar[XB_XSUB(b.x)], 1u);
        const unsigned gen = old / nloc;
        if (old + 1u == (gen + 1u) * nloc) {
            __builtin_amdgcn_fence(__ATOMIC_RELEASE, "agent");
            asm volatile("s_waitcnt vmcnt(0)" ::: "memory");
            const unsigned og = xb_add(&bar[XB_TOP], 1u);
            const unsigned tg = og / nx;
            if (og + 1u == (tg + 1u) * nx) xb_add(&bar[XB_TOPGEN], 1u);
            else XB_SPIN(xb_ld(&bar[XB_TOPGEN]) == tg, bar);
            __builtin_amdgcn_fence(__ATOMIC_ACQUIRE, "agent");
            xb_add(&bar[XB_XGEN(b.x)], 1u);
            asm volatile("s_waitcnt vmcnt(0)" ::: "memory");
        } else {
            XB_SPIN(xb_ld(&bar[XB_XGEN(b.x)]) == gen, bar);
            __builtin_amdgcn_fence(__ATOMIC_ACQUIRE, "agent");
            asm volatile("s_waitcnt vmcnt(0)" ::: "memory");
        }
    }
    __syncthreads();
}

struct Args { const float* in[24]; float* out; unsigned char* ws; int ph_lo, ph_hi; };
enum { I_X = 0, I_C, I_N1G, I_WIN, I_WG2, I_BG, I_GONG, I_LNG, I_LNB, I_SWS, I_SBS, I_SONG, I_WOUT, I_N2G, I_RGW, I_RGB, I_REW, I_REB, I_EWG, I_EWU, I_EWD, I_ADAW, I_ADAB, I_FING };

struct Ctx {
    LAS unsigned char* lds;
    int tid, lane, wave, G, bid;
    const float* const* in;
    unsigned char* ws;
    float* out;
};

struct EpiInProj {
    static constexpr bool PERM = true;
    bf16_t* P; const float* bg;
    template <int MODE> __device__ __forceinline__ void run(const f32x4 (&acc)[2][2][4][2], const pg8::Unit& u, int wr, int wc, int fr, int fq) const {
        const int row0 = u.row0 + wr * 64 + fr, col0 = u.col0 + wc * 32 + 8 * fq;
        f32x4 bv[2][2];
#pragma unroll
        for (int bj = 0; bj < 2; ++bj)
#pragma unroll
            for (int n = 0; n < 2; ++n) bv[bj][n] = (MODE == 2) ? *(const f32x4*)(bg + (col0 - PG) + bj * 128 + 4 * n) : (f32x4){0.f, 0.f, 0.f, 0.f};
#pragma unroll
        for (int ai = 0; ai < 2; ++ai)
#pragma unroll
            for (int m = 0; m < 4; ++m) {
                bf16_t* rowp = P + (size_t)(row0 + ai * 128 + m * 16) * NP + col0;
#pragma unroll
                for (int bj = 0; bj < 2; ++bj) {
                    float v[8];
#pragma unroll
                    for (int n = 0; n < 2; ++n)
#pragma unroll
                        for (int j = 0; j < 4; ++j) {
                            float x = acc[ai][bj][m][n][j];
                            if (MODE == 0) x *= 0.125f;
                            else if (MODE == 2) x = logsig_f(x + bv[bj][n][j]) * 0.0625f;
                            else if (MODE == 3) x = silu_f(x);
                            else if (MODE == 4) x = gelu_tanh_f(x);
                            v[n * 4 + j] = x;
                        }
                    u32x4 w; w.x = cvt_pk_bf16(v[0], v[1]); w.y = cvt_pk_bf16(v[2], v[3]); w.z = cvt_pk_bf16(v[4], v[5]); w.w = cvt_pk_bf16(v[6], v[7]);
                    *(u32x4*)(rowp + bj * 128) = w;
                }
            }
    }
    __device__ __forceinline__ void operator()(const f32x4 (&acc)[2][2][4][2], const pg8::Unit& u, int wr, int wc, int fr, int fq) const {
        const int pn = u.col0 >> 8;
        if (pn == 0) run<0>(acc, u, wr, wc, fr, fq);
        else if (pn == 2) run<2>(acc, u, wr, wc, fr, fq);
        else if (pn == 5 || pn == 6) run<3>(acc, u, wr, wc, fr, fq);
        else if (pn >= 7) run<4>(acc, u, wr, wc, fr, fq);
        else run<1>(acc, u, wr, wc, fr, fq);
    }
};

struct EpiOutProj {
    static constexpr bool PERM = true;
    const float* xin; float* xout; const float* gate;
    __device__ __forceinline__ void operator()(const f32x4 (&acc)[2][2][4][2], const pg8::Unit& u, int wr, int wc, int fr, int fq) const {
        const int row0 = u.row0 + wr * 64 + fr, col0 = u.col0 + wc * 32 + 8 * fq;
        const float* g = gate + (u.row0 >= SEQ ? 6144 : 0) + col0;
        f32x4 gv[2][2];
#pragma unroll
        for (int bj = 0; bj < 2; ++bj)
#pragma unroll
            for (int n = 0; n < 2; ++n) gv[bj][n] = *(const f32x4*)(g + bj * 128 + 4 * n);
#pragma unroll
        for (int ai = 0; ai < 2; ++ai)
#pragma unroll
            for (int m = 0; m < 4; ++m) {
                const size_t off = (size_t)(row0 + ai * 128 + m * 16) * D + col0;
#pragma unroll
                for (int bj = 0; bj < 2; ++bj)
#pragma unroll
                    for (int n = 0; n < 2; ++n) {
                        const f32x4 xo = *(const f32x4*)(xin + off + bj * 128 + 4 * n);
                        *(f32x4*)(xout + off + bj * 128 + 4 * n) = xo + gv[bj][n] * acc[ai][bj][m][n];
                    }
            }
    }
};

struct EpiMoe1 {
    static constexpr bool PERM = true;
    bf16_t* ACT; const float* wl;
    __device__ __forceinline__ void operator()(const f32x4 (&acc)[2][2][4][2], const pg8::Unit& u, int wr, int wc, int fr, int fq) const {
        const int col0 = u.col0 + wc * 32 + 8 * fq;
#pragma unroll
        for (int ai = 0; ai < 2; ++ai)
#pragma unroll
            for (int m = 0; m < 4; ++m) {
                const int rt = ai * 128 + wr * 64 + m * 16 + fr;
                if (rt < u.nvalid) {
                    const float w = wl[u.toff + rt];
                    float v[8];
#pragma unroll
                    for (int n = 0; n < 2; ++n)
#pragma unroll
                        for (int j = 0; j < 4; ++j) v[n * 4 + j] = silu_f(acc[ai][0][m][n][j]) * acc[ai][1][m][n][j] * w;
                    u32x4 o; o.x = cvt_pk_bf16(v[0], v[1]); o.y = cvt_pk_bf16(v[2], v[3]); o.z = cvt_pk_bf16(v[4], v[5]); o.w = cvt_pk_bf16(v[6], v[7]);
                    *(u32x4*)(ACT + (size_t)(u.row0 + rt) * 256 + col0) = o;
                }
            }
    }
};

struct EpiMoe2 {
    static constexpr bool PERM = true;
    bf16_t* Y;
    __device__ __forceinline__ void operator()(const f32x4 (&acc)[2][2][4][2], const pg8::Unit& u, int wr, int wc, int fr, int fq) const {
        const int col0 = u.col0 + wc * 32 + 8 * fq;
#pragma unroll
        for (int ai = 0; ai < 2; ++ai)
#pragma unroll
            for (int m = 0; m < 4; ++m) {
                const int rt = ai * 128 + wr * 64 + m * 16 + fr;
                if (rt < u.nvalid) {
                    bf16_t* rowp = Y + (size_t)(u.row0 + rt) * D + col0;
#pragma unroll
                    for (int bj = 0; bj < 2; ++bj) {
                        const f32x4 v0 = acc[ai][bj][m][0], v1 = acc[ai][bj][m][1];
                        u32x4 o; o.x = cvt_pk_bf16(v0[0], v0[1]); o.y = cvt_pk_bf16(v0[2], v0[3]); o.z = cvt_pk_bf16(v1[0], v1[1]); o.w = cvt_pk_bf16(v1[2], v1[3]);
                        *(u32x4*)(rowp + bj * 128) = o;
                    }
                }
            }
    }
};

struct MoeTables { const LAS int* tp; const LAS int* cnt; const LAS int* base; const LAS int* ue; };
#define RFL(x) __builtin_amdgcn_readfirstlane(x)
struct MoeSched1 {
    static constexpr bool GATHER = true, PARTIAL = true;
    MoeTables tb; const char* A; const char* B; const int* tok; int G, c;
    __device__ __forceinline__ bool next(int i, pg8::Unit& u) const {
        if (i >= 16) return false;
        const int em = RFL(tb.ue[i]); if (em < 0) return false;
        const int e = em >> 8, mt = em & 255, nt = (i * G + c) & 1;
        const int nv = RFL(tb.cnt[e]) - mt * 256;
        u.arow = 0; u.brow = e * 512 + nt * 256; u.row0 = RFL(tb.base[e]) + mt * 256; u.col0 = nt * 128; u.nvalid = nv < 256 ? nv : 256; u.toff = e * T + mt * 256; return true;
    }
};
struct MoeSched2 {
    static constexpr bool GATHER = false, PARTIAL = true;
    MoeTables tb; const char* A; const char* B; const int* tok; int G, c;
    __device__ __forceinline__ bool next(int i, pg8::Unit& u) const {
        if (i >= 16) return false;
        const int em = RFL(tb.ue[i]); if (em < 0) return false;
        const int e = em >> 8, mt = em & 255, nt = (i * G + c) & 3;
        const int nv = RFL(tb.cnt[e]) - mt * 256;
        u.row0 = RFL(tb.base[e]) + mt * 256; u.arow = u.row0; u.brow = e * 1024 + nt * 256; u.col0 = nt * 256; u.nvalid = nv < 256 ? nv : 256; u.toff = 0; return true;
    }
};

__global__ void __launch_bounds__(NWAVES * 64, 2) fwd_kernel(Args args) {
    extern __shared__ __attribute__((aligned(16))) unsigned char lds_raw[];
    LAS unsigned char* lds = (LAS unsigned char*)lds_raw;
    const int tid0 = threadIdx.x, G0 = gridDim.x, bid0 = blockIdx.x;
#define PHASE_BEGIN() \
    int tid = tid0, bid = bid0, G = G0, l = l0; \
    asm volatile("" : "+v"(tid), "+s"(bid), "+s"(G), "+s"(l) :: "memory"); KSEG_FENCE(); \
    const int lane = tid & 63, wave = __builtin_amdgcn_readfirstlane(tid >> 6), gw = bid * NWAVES + wave, NGW = G * NWAVES; \
    const float* modl = MOD + (size_t)l * 2 * 6144; (void)lane; (void)wave; (void)gw; (void)NGW; (void)modl
    const CAS unsigned char* kseg = (const CAS unsigned char*)__builtin_amdgcn_kernarg_segment_ptr();
#define KSEG_FENCE() asm volatile("" : "+s"(kseg) :: "memory")
#define KIN(i) (*(const float* const CAS*)(kseg + 8 * (i)))
#define K_OUT (*(float* const CAS*)(kseg + 192))
#define K_WS (*(unsigned char* const CAS*)(kseg + 200))
#define WSP(type, off) ((type*)(K_WS + (off)))
#define ctl WSP(unsigned, WS_CTL)
#define MOD WSP(float, WS_MOD)
#define WRH WSP(bf16_t, WS_WRH)
#define WRL WSP(bf16_t, WS_WRL)
#define SHW WSP(float, WS_SHW)
#define TOK WSP(int, WS_TOK)
#define WL WSP(float, WS_WL)
#define REF WSP(int, WS_REF)
#define DECAY WSP(float, WS_DECAY)
#define WIN WSP(bf16_t, WS_WIN)
#define WOUT WSP(bf16_t, WS_WOUT)
#define WGU WSP(bf16_t, WS_WGU)
#define WD WSP(bf16_t, WS_WD)
#define H WSP(bf16_t, WS_H)
#define P WSP(bf16_t, WS_P)
#define Y WSP(bf16_t, WS_Y)
#define KVT WSP(float, WS_KVT)
#define ACT WSP(bf16_t, WS_ACT)
#define ST WSP(bf16_t, WS_ST)
#define OMIX WSP(bf16_t, WS_OMIX)
#define VT WSP(bf16_t, WS_VT)
#define XOUT K_OUT
    volatile LAS unsigned* MISC = (volatile LAS unsigned*)(lds + MISC_OFF);
    LAS int* TB_TP = (LAS int*)(lds + MISC_OFF + 64);
    LAS int* TB_CNT = (LAS int*)(lds + MISC_OFF + 256);
    LAS int* TB_BASE = (LAS int*)(lds + MISC_OFF + 448);
    LAS int* TB_UE = (LAS int*)(lds + MISC_OFF + 640);
    LAS int* TB_TILE = (LAS int*)(lds + MISC_OFF + 1024);

    for (int u = tid0; u < 512; u += NWAVES * 64) ((LAS unsigned*)(lds + MISC_OFF))[u] = 0u;
    __syncthreads();
    unsigned my_xcc = 0;
    if (!MK_SPLIT) { XcdBarrier b0 = xcd_barrier_post(ctl + CW_BAR, MISC + 0); my_xcc = b0.x; }
    const int lo = *(const int CAS*)(kseg + 208), hi = *(const int CAS*)(kseg + 212);
#ifndef PHMASK
#define PHMASK 0x7ff
#endif
#define PHT(k) ((k) < 2 ? (k) : 2 + ((k) - 2) % 9)
#define IN(k) (((PHMASK >> PHT(k)) & 1) && lo <= (k) && (k) < hi)
#ifndef DUPMASK
#define DUPMASK 0
#endif
#define NREP(k) (1 + ((DUPMASK >> PHT(k)) & 1))
#define REP_BEGIN(k) for (int _rep = 0; _rep < NREP(k); ++_rep) { const bool dry = (NREP(k) > 1) && (_rep == 0); (void)dry; if (_rep) { KSEG_FENCE(); XcdBarrier _b; _b.bar = ctl + CW_BAR; _b.x = my_xcc; _b.st = MISC; xcd_barrier(_b); }
#define REP_END() }
#define SEAM(k) do { if (IN(k) && IN((k) + 1)) { KSEG_FENCE(); XcdBarrier _b; _b.bar = ctl + CW_BAR; _b.x = my_xcc; _b.st = MISC; xcd_barrier(_b); } KSEG_FENCE(); } while (0)

    if (IN(0)) { REP_BEGIN(0)
        const int l0 = 0; PHASE_BEGIN();
        {
            LAS float* cact = (LAS float*)lds;
            LAS float* part = (LAS float*)(lds + 8192);
            for (int i = tid; i < 2 * D; i += NWAVES * 64) cact[i] = silu_f(KIN(I_C)[i]);
            __syncthreads();
            const int jj = tid & 31, ks = tid >> 5;
            for (int item = bid; item < DEPTH * 192; item += G) {
                const int l = item / 192, j0 = (item % 192) * 32;
                const float* w = KIN(I_ADAW) + (size_t)l * D * 6144 + (size_t)(ks * 64) * 6144 + j0 + jj;
                float a0 = 0.f, a1 = 0.f;
#pragma unroll 16
                for (int k = 0; k < 64; ++k) { const float wv = w[(size_t)k * 6144]; a0 += cact[ks * 64 + k] * wv; a1 += cact[D + ks * 64 + k] * wv; }
                part[(ks * 32 + jj) * 2 + 0] = a0; part[(ks * 32 + jj) * 2 + 1] = a1;
                __syncthreads();
                if (tid < 64) { const int j = tid & 31, b = tid >> 5; float s = KIN(I_ADAB)[l * 6144 + j0 + j];
#pragma unroll
                    for (int q = 0; q < 16; ++q) s += part[(q * 32 + j) * 2 + b];
                    MOD[(size_t)(l * 2 + b) * 6144 + j0 + j] = s; }
                __syncthreads();
            }
        }
        {
            for (int i = bid * (NWAVES * 64) + tid; i < DEPTH * 64 * D; i += G * NWAVES * 64) {
                const int l = i / (64 * D), r = i % (64 * D), e = r / D, k = r % D;
                const float w = (e < 32) ? KIN(I_REW)[((size_t)l * D + k) * 32 + e] : ((e < 36) ? KIN(I_RGW)[((size_t)l * D + k) * 4 + (e - 32)] : 0.f);
                ((_Float16*)WRH)[i] = (_Float16)w;
            }
        }
        {
            LAS float* scr = (LAS float*)(lds + wave * 16384);
            constexpr int NI_IN = 16 * 88, NI_OUT = 16 * 32, NI_GU = 32 * 2 * 16 * 8, NI_DN = 32 * 4 * 32, NL = NI_IN + NI_OUT + NI_GU + NI_DN;
            for (int it = gw; it < DEPTH * NL; it += NGW) {
                const int l = it / NL; int r = it % NL;
                const float* src; int lds_src; bf16_t* dst; int ld_dst; bool gk = false; int gk_n0 = 0, gk_k0 = 0;
                if (r < NI_IN) { const int kb = r / 88, db = r % 88, n0 = 32 * db;
                    dst = WIN + ((size_t)l * NP + n0) * D + 64 * kb; ld_dst = D; lds_src = INC;
                    if (db >= 16 && db < 24) { gk = true; gk_n0 = n0 - PG; gk_k0 = 64 * kb; src = KIN(I_WIN) + (size_t)l * D * INC; }
                    else { const int sc = n0 < 512 ? n0 : (n0 < PU ? n0 - 256 : n0 - 240); src = KIN(I_WIN) + (size_t)l * D * INC + (size_t)(64 * kb) * INC + sc; }
                } else if ((r -= NI_IN) < NI_OUT) { const int kb = r / 32, nb = r % 32;
                    src = KIN(I_WOUT) + (size_t)l * D * D + (size_t)(64 * kb) * D + 32 * nb; lds_src = D; dst = WOUT + ((size_t)l * D + 32 * nb) * D + 64 * kb; ld_dst = D;
                } else if ((r -= NI_OUT) < NI_GU) { const int e = r / 256, q = r % 256, which = q / 128, q2 = q % 128, kb = q2 / 8, nb = q2 % 8, f0 = 32 * nb;
                    const int drow = (f0 >> 7) * 256 + which * 128 + (f0 & 127);
                    src = KIN(which ? I_EWU : I_EWG) + ((size_t)(l * 32 + e) * D + 64 * kb) * 256 + f0; lds_src = 256;
                    dst = WGU + ((size_t)(l * 32 + e) * 512 + drow) * D + 64 * kb; ld_dst = D;
                } else { r -= NI_GU; const int e = r / 128, q = r % 128, kb = q / 32, nb = q % 32;
                    src = KIN(I_EWD) + ((size_t)(l * 32 + e) * 256 + 64 * kb) * D + 32 * nb; lds_src = D;
                    dst = WD + ((size_t)(l * 32 + e) * D + 32 * nb) * 256 + 64 * kb; ld_dst = 256;
                }
                if (gk) {
                    const float* wg2 = KIN(I_WG2) + (size_t)l * 16 * 256;
#pragma unroll 4
                    for (int i = 0; i < 32; ++i) { const int kk = 2 * i + (lane >> 5), nn = lane & 31; const float* wl = src + (size_t)(gk_k0 + kk) * INC + 1536; float s = 0.f;
#pragma unroll
                        for (int q = 0; q < 16; ++q) s += wl[q] * wg2[q * 256 + gk_n0 + nn];
                        scr[kk * 33 + nn] = s; }
                } else {
#pragma unroll 8
                    for (int i = 0; i < 32; ++i) { const int kk = 2 * i + (lane >> 5); scr[kk * 33 + (lane & 31)] = src[(size_t)kk * lds_src + (lane & 31)]; }
                }
                LDS_WAIT(); asm volatile("" ::: "memory");
                const int c = lane & 7;
#pragma unroll
                for (int j = 0; j < 4; ++j) { const int n = (lane >> 3) + 8 * j; const LAS float* s = scr + (8 * c) * 33 + n;
                    u32x4 o; o.x = cvt_pk_bf16(s[0 * 33], s[1 * 33]); o.y = cvt_pk_bf16(s[2 * 33], s[3 * 33]); o.z = cvt_pk_bf16(s[4 * 33], s[5 * 33]); o.w = cvt_pk_bf16(s[6 * 33], s[7 * 33]);
                    *(u32x4*)(dst + (size_t)n * ld_dst + 8 * c) = o; }
                LDS_WAIT(); asm volatile("" ::: "memory");
            }
        }
    REP_END() }
    SEAM(0);

#define NORM_ROW(xrow, hrow, gp, scp, shp) do { \
        f32x4 _v[4]; float _s = 0.f; \
        _Pragma("unroll") for (int _j = 0; _j < 4; ++_j) { _v[_j] = *((const f32x4*)(xrow) + lane + 64 * _j); _s += (_v[_j].x * _v[_j].x + _v[_j].y * _v[_j].y) + (_v[_j].z * _v[_j].z + _v[_j].w * _v[_j].w); } \
        const float _r = __builtin_amdgcn_rsqf(wave_sum(_s) * (1.f / D) + EPS); \
        _Pragma("unroll") for (int _j = 0; _j < 4; ++_j) { const f32x4 _g = *((const f32x4*)(gp) + lane + 64 * _j), _sc = *((const f32x4*)(scp) + lane + 64 * _j), _sh = *((const f32x4*)(shp) + lane + 64 * _j); \
            const f32x4 _h = (_v[_j] * _r) * _g * (_sc + 1.f) + _sh; u32x2 _o; _o.x = cvt_pk_bf16(_h.x, _h.y); _o.y = cvt_pk_bf16(_h.z, _h.w); *((u32x2*)(hrow) + lane + 64 * _j) = _o; } } while (0)

    if (IN(1)) { REP_BEGIN(1)
        const int l0 = 0; PHASE_BEGIN();
        for (int m = gw; m < T; m += NGW) { const float* md = MOD + (size_t)(m >= SEQ ? 1 : 0) * 6144;
            NORM_ROW(KIN(I_X) + (size_t)m * D, H + (size_t)m * D, KIN(I_N1G), md + 1024, md); }
        for (int it = gw; it < DEPTH * 2 * 36; it += NGW) {
            const int ll = it / 72, b = (it % 72) / 36, e = it % 36;
            const float* sh = MOD + (size_t)(ll * 2 + b) * 6144 + 3072; float s = 0.f;
            for (int k = lane; k < D; k += 64) s += sh[k] * ((e < 32) ? KIN(I_REW)[((size_t)ll * D + k) * 32 + e] : KIN(I_RGW)[((size_t)ll * D + k) * 4 + (e - 32)]);
            s = wave_sum(s);
            if (lane == 0) SHW[(ll * 2 + b) * 64 + e] = s + ((e < 32) ? KIN(I_REB)[ll * 32 + e] : KIN(I_RGB)[ll * 4 + (e - 32)]);
        }
    REP_END() }
    SEAM(1);

    for (int l0 = 0; l0 < DEPTH; ++l0) {
        const int pb = 2 + 9 * l0;
        if (IN(pb + 0)) { REP_BEGIN(pb + 0)
            PHASE_BEGIN();
            pg8::DenseSched S; S.init(H, WIN + (size_t)l * NP * D, T, NP, G, bid);
            EpiInProj E{P, KIN(I_BG) + l * 256};
            pg8::gemm_phase<EpiInProj, pg8::DenseSched>(lds, tid, D, S, E);
        REP_END() }
        SEAM(pb + 0);

        if (IN(pb + 1)) { REP_BEGIN(pb + 1)
            PHASE_BEGIN();
#if MFMA_G1
            {
                LAS unsigned char* ET = lds;
                LAS unsigned char* VI = lds + 9216;
                LAS float* segtot = (LAS float*)(lds + 9216 + 17408);
                const int col = tid & 63, seg = tid >> 6;
                const int r32 = lane & 31, hf = lane >> 5, blk16 = (lane >> 4) & 1, tq = (lane & 15) >> 2, tp = lane & 3;
                for (int unit = bid; unit < NCH * 4; unit += G) {
                    const int cn = unit >> 2, hh = unit & 3;
                    bf16_t* Pc = P + (size_t)(cn * 64) * NP; bf16_t* Pw = dry ? Pc + (WS_DRY - WS_P) / 2 : Pc;
                    float g[8], kk[8], qq[8]; float run = 0.f;
#pragma unroll
                    for (int i = 0; i < 8; ++i) { const size_t ro = (size_t)(seg * 8 + i) * NP; run += bf2f(Pc[ro + PG + hh * 64 + col]); g[i] = run; kk[i] = bf2f(Pc[ro + PK + hh * 64 + col]); qq[i] = bf2f(Pc[ro + PQ + hh * 64 + col]); }
                    segtot[seg * 64 + col] = run;
#pragma unroll
                    for (int i = 0; i < 2; ++i) { const int idx = tid + 512 * i, row = idx >> 4, ch = idx & 15;
                        *(LAS u32x4*)(VI + row * 272 + ch * 16) = *(const u32x4*)(Pc + (size_t)row * NP + PV + hh * 128 + ch * 8); }
                    __syncthreads();
                    float offs = 0.f, blast = 0.f;
#pragma unroll
                    for (int s = 0; s < 8; ++s) { const float tv = segtot[s * 64 + col]; if (s < seg) offs += tv; blast += tv; }
                    float ke[8];
#pragma unroll
                    for (int i = 0; i < 8; ++i) { const float bb = offs + g[i]; const size_t ro = (size_t)(seg * 8 + i) * NP;
                        Pw[ro + PQ + hh * 64 + col] = f2bf(qq[i] * __expf(bb)); Pw[ro + PK + hh * 64 + col] = f2bf(kk[i] * __expf(-bb)); ke[i] = kk[i] * __expf(blast - bb); }
                    *(LAS bf16x8*)(ET + col * 144 + seg * 16) = pack8(ke[0], ke[1], ke[2], ke[3], ke[4], ke[5], ke[6], ke[7]);
                    if (seg == 0) DECAY[(size_t)unit * 64 + col] = __expf(blast);
                    __syncthreads();
                    {
                        const int vt = wave >> 1, kt = wave & 1;
                        f32x16 acc;
#pragma unroll
                        for (int r = 0; r < 16; ++r) acc[r] = 0.f;
#pragma unroll
                        for (int ks = 0; ks < 4; ++ks) {
                            const LAS unsigned char* ta = VI + (16 * ks + 8 * hf + tq) * 272 + (32 * vt + 16 * blk16 + 4 * tp) * 2;
                            const bf16x8 a = cat4(lds_tr(ta), lds_tr(ta + 4 * 272));
                            const bf16x8 b = *(const LAS bf16x8*)(ET + (32 * kt + r32) * 144 + (16 * ks + 8 * hf) * 2);
                            acc = MFMA32(a, b, acc);
                            if (kt == 0) *(bf16x8*)(VT + ((size_t)unit * 128 + 32 * vt + r32) * 64 + 16 * ks + 8 * hf) = a;
                        }
#pragma unroll
                        for (int r = 0; r < 16; ++r) KVT[((size_t)unit * 128 + 32 * vt + (r & 3) + 8 * (r >> 2) + 4 * hf) * 64 + 32 * kt + r32] = acc[r];
                    }
                    __syncthreads();
                }
            }
#else
            {
                LAS float* ke = (LAS float*)lds;
                LAS float* vv = (LAS float*)(lds + 16384);
                LAS float* segtot = (LAS float*)(lds + 49152);
                const int col = tid & 63, seg = tid >> 6;
                for (int unit = bid; unit < NCH * 4; unit += G) {
                    const int cn = unit >> 2, h = unit & 3;
                    bf16_t* Pc = P + (size_t)(cn * 64) * NP;
                    float g[8], kk[8], qq[8]; float run = 0.f;
#pragma unroll
                    for (int i = 0; i < 8; ++i) { const size_t ro = (size_t)(seg * 8 + i) * NP; run += bf2f(Pc[ro + PG + h * 64 + col]); g[i] = run; kk[i] = bf2f(Pc[ro + PK + h * 64 + col]); qq[i] = bf2f(Pc[ro + PQ + h * 64 + col]); }
                    segtot[seg * 64 + col] = run;
#pragma unroll
                    for (int i = 0; i < 16; ++i) { const int idx = tid + 512 * i, p = idx >> 7, vd = idx & 127; vv[p * 128 + vd] = bf2f(Pc[(size_t)p * NP + PV + h * 128 + vd]); }
                    __syncthreads();
                    float offs = 0.f, blast = 0.f;
#pragma unroll
                    for (int s = 0; s < 8; ++s) { const float tv = segtot[s * 64 + col]; if (s < seg) offs += tv; blast += tv; }
#pragma unroll
                    for (int i = 0; i < 8; ++i) { const float bb = offs + g[i]; const size_t ro = (size_t)(seg * 8 + i) * NP;
                        Pc[ro + PQ + h * 64 + col] = f2bf(qq[i] * __expf(bb)); Pc[ro + PK + h * 64 + col] = f2bf(kk[i] * __expf(-bb)); ke[(seg * 8 + i) * 64 + col] = kk[i] * __expf(blast - bb); }
                    if (seg == 0) DECAY[(size_t)(cn * 4 + h) * 64 + col] = __expf(blast);
#pragma unroll
                    for (int i = 0; i < 16; ++i) { const int idx = tid + 512 * i, vd = idx >> 6, j = idx & 63; VT[((size_t)unit * 128 + vd) * 64 + j] = f2bf(vv[j * 128 + vd]); }
                    __syncthreads();
                    {
                        const int vd = tid & 127, kd0 = (tid >> 7) * 16; float a[16];
#pragma unroll
                        for (int q = 0; q < 16; ++q) a[q] = 0.f;
                        for (int j = 0; j < 64; ++j) { const float x = vv[j * 128 + vd];
#pragma unroll
                            for (int q = 0; q < 16; ++q) a[q] += ke[j * 64 + kd0 + q] * x; }
                        float* o = KVT + ((size_t)(cn * 4 + h) * 128 + vd) * 64 + kd0;
#pragma unroll
                        for (int q = 0; q < 4; ++q) *(f32x4*)(o + 4 * q) = (f32x4){a[4 * q], a[4 * q + 1], a[4 * q + 2], a[4 * q + 3]};
                    }
                    __syncthreads();
                }
            }
#endif
#if MFMA_SGU
            for (int _r2 = 0; _r2 < 1 + ((DUPMASK >> 12) & 1); ++_r2)
            {
                LAS unsigned char* vimg = lds;
                const float* lng = KIN(I_LNG) + l * 512; const float* lnb = KIN(I_LNB) + l * 512;
                const int r32 = lane & 31, hf = lane >> 5, blk16 = (lane >> 4) & 1, tq = (lane & 15) >> 2, tp = lane & 3;
                for (int unit = bid; unit < 256; unit += G) {
                    const int gp = unit & 1, blk = (unit >> 1) & 63, b = unit >> 7;
                    const int t0 = b * SEQ + blk * 128;
                    {
                        const int row = tid >> 2, part = tid & 3;
                        const bf16_t* pr = P + (size_t)(t0 + row) * NP + PSV;
                        float s = 0.f, s2 = 0.f;
#pragma unroll 4
                        for (int c = 0; c < 128; c += 8) { const u32x4 w = *(const u32x4*)(pr + part * 128 + c);
#pragma unroll
                            for (int q = 0; q < 4; ++q) { const float x0 = bflo(w[q]), x1 = bfhi(w[q]); s += x0 + x1; s2 += x0 * x0 + x1 * x1; } }
                        s += __shfl_xor(s, 1); s += __shfl_xor(s, 2); s2 += __shfl_xor(s2, 1); s2 += __shfl_xor(s2, 2);
                        const float mean = s * (1.f / 512.f); const float var = fmaxf(s2 * (1.f / 512.f) - mean * mean, 0.f); const float rstd = __builtin_amdgcn_rsqf(var + EPS);
                        const int cb = 256 * gp + 64 * part;
#pragma unroll
                        for (int c8 = 0; c8 < 8; ++c8) { const u32x4 w = *(const u32x4*)(pr + cb + 8 * c8);
                            const f32x4 g0 = *(const f32x4*)(lng + cb + 8 * c8), g1 = *(const f32x4*)(lng + cb + 8 * c8 + 4), b0 = *(const f32x4*)(lnb + cb + 8 * c8), b1 = *(const f32x4*)(lnb + cb + 8 * c8 + 4);
                            *(LAS bf16x8*)(vimg + row * 528 + (64 * part + 8 * c8) * 2) = pack8(
                                (bflo(w[0]) - mean) * rstd * g0[0] + b0[0], (bfhi(w[0]) - mean) * rstd * g0[1] + b0[1], (bflo(w[1]) - mean) * rstd * g0[2] + b0[2], (bfhi(w[1]) - mean) * rstd * g0[3] + b0[3],
                                (bflo(w[2]) - mean) * rstd * g1[0] + b1[0], (bfhi(w[2]) - mean) * rstd * g1[1] + b1[1], (bflo(w[3]) - mean) * rstd * g1[2] + b1[2], (bfhi(w[3]) - mean) * rstd * g1[3] + b1[3]); }
                    }
                    __syncthreads();
                    {
                        const int gs = wave >> 2, it = wave & 3, g = 2 * gp + gs;
                        f32x16 acc[4];
#pragma unroll
                        for (int ct = 0; ct < 4; ++ct)
#pragma unroll
                            for (int r = 0; r < 16; ++r) acc[ct][r] = 0.f;
                        const float* wrow = KIN(I_SWS) + ((size_t)(l * 4 + g) * 128 + 32 * it + r32) * 128 + 8 * hf;
                        const LAS unsigned char* tbase = vimg + (8 * hf + tq) * 528 + (128 * gs + 16 * blk16 + 4 * tp) * 2;
                        const int nks = (it < 2) ? 4 : 8;
                        for (int ks = 0; ks < nks; ++ks) {
                            const f32x4 w0 = *(const f32x4*)(wrow + 16 * ks), w1 = *(const f32x4*)(wrow + 16 * ks + 4);
                            const bf16x8 bw = pack8(w0[0], w0[1], w0[2], w0[3], w1[0], w1[1], w1[2], w1[3]);
#pragma unroll
                            for (int ct = 0; ct < 4; ++ct) { const LAS unsigned char* ta = tbase + (16 * ks) * 528 + (32 * ct) * 2;
                                acc[ct] = MFMA32(cat4(lds_tr(ta), lds_tr(ta + 4 * 528)), bw, acc[ct]); }
                        }
                        const int i = 32 * it + r32, t = t0 + i;
                        const float bs = KIN(I_SBS)[(l * 4 + g) * 128 + i];
                        const bf16_t* ur = P + (size_t)t * NP + PU + g * 128 + 4 * hf;
                        float ss = 0.f;
#pragma unroll
                        for (int ct = 0; ct < 4; ++ct)
#pragma unroll
                            for (int g4 = 0; g4 < 4; ++g4) { const u32x2 uw = *(const u32x2*)(ur + 32 * ct + 8 * g4);
                                const float u0 = bflo(uw.x), u1 = bfhi(uw.x), u2 = bflo(uw.y), u3 = bfhi(uw.y);
                                acc[ct][4 * g4 + 0] = u0 * (acc[ct][4 * g4 + 0] + bs); acc[ct][4 * g4 + 1] = u1 * (acc[ct][4 * g4 + 1] + bs); acc[ct][4 * g4 + 2] = u2 * (acc[ct][4 * g4 + 2] + bs); acc[ct][4 * g4 + 3] = u3 * (acc[ct][4 * g4 + 3] + bs);
                                ss += (acc[ct][4 * g4] * acc[ct][4 * g4] + acc[ct][4 * g4 + 1] * acc[ct][4 * g4 + 1]) + (acc[ct][4 * g4 + 2] * acc[ct][4 * g4 + 2] + acc[ct][4 * g4 + 3] * acc[ct][4 * g4 + 3]); }
                        ss += __shfl_xor(ss, 32);
                        const float rs = __builtin_amdgcn_rsqf(ss * (1.f / 128.f) + EPS);
                        const float* og = KIN(I_SONG) + (l * 4 + g) * 128 + 4 * hf;
                        bf16_t* orow = OMIX + (size_t)t * D + 512 + g * 128 + 4 * hf;
#pragma unroll
                        for (int ct = 0; ct < 4; ++ct)
#pragma unroll
                            for (int g4 = 0; g4 < 4; ++g4) { const f32x4 ov = *(const f32x4*)(og + 32 * ct + 8 * g4);
                                u32x2 o; o.x = cvt_pk_bf16(acc[ct][4 * g4] * rs * ov[0], acc[ct][4 * g4 + 1] * rs * ov[1]); o.y = cvt_pk_bf16(acc[ct][4 * g4 + 2] * rs * ov[2], acc[ct][4 * g4 + 3] * rs * ov[3]);
                                *(u32x2*)(orow + 32 * ct + 8 * g4) = o; }
                    }
                    __syncthreads();
                }
            }
#else
            {
                LAS float* vn = (LAS float*)lds;
                const float* lng = KIN(I_LNG) + l * 512; const float* lnb = KIN(I_LNB) + l * 512;
                for (int unit = bid; unit < 2 * 64 * 4; unit += G) {
                    const int g = unit & 3, blk = (unit >> 2) & 63, b = unit >> 8;
                    const int t0 = b * SEQ + blk * 128;
                    const int row = tid >> 2, part = tid & 3;
                    const bf16_t* pr = P + (size_t)(t0 + row) * NP + PSV;
                    float s = 0.f, s2 = 0.f;
                    for (int c = 0; c < 128; c += 8) { const u32x4 w = *(const u32x4*)(pr + part * 128 + c);
#pragma unroll
                        for (int q = 0; q < 4; ++q) { const float x0 = __builtin_bit_cast(float, w[q] << 16), x1 = __builtin_bit_cast(float, w[q] & 0xffff0000u); s += x0 + x1; s2 += x0 * x0 + x1 * x1; } }
                    s += __shfl_xor(s, 1); s += __shfl_xor(s, 2); s2 += __shfl_xor(s2, 1); s2 += __shfl_xor(s2, 2);
                    const float mean = s * (1.f / 512.f); const float var = fmaxf(s2 * (1.f / 512.f) - mean * mean, 0.f); const float rstd = __builtin_amdgcn_rsqf(var + EPS);
                    for (int c = 0; c < 32; ++c) { const int cc = part * 32 + c; vn[row * 128 + cc] = (bf2f(pr[g * 128 + cc]) - mean) * rstd * lng[g * 128 + cc] + lnb[g * 128 + cc]; }
                    __syncthreads();
                    {
                        const int i = tid >> 2, c0 = (tid & 3) * 32; float a[32];
#pragma unroll
                        for (int q = 0; q < 32; ++q) a[q] = 0.f;
                        const float* wrow = KIN(I_SWS) + ((size_t)(l * 4 + g) * 128 + i) * 128;
                        const int jlim = (i < 64) ? 64 : 128;
                        for (int j = 0; j < jlim; ++j) { const float w = wrow[j];
#pragma unroll
                            for (int q = 0; q < 32; ++q) a[q] += w * vn[j * 128 + c0 + q]; }
                        const float bs = KIN(I_SBS)[(l * 4 + g) * 128 + i];
                        const bf16_t* ur = P + (size_t)(t0 + i) * NP + PU + g * 128 + c0;
                        float ss = 0.f;
#pragma unroll
                        for (int q = 0; q < 32; ++q) { a[q] = bf2f(ur[q]) * (a[q] + bs); ss += a[q] * a[q]; }
                        ss += __shfl_xor(ss, 1); ss += __shfl_xor(ss, 2);
                        const float r = __builtin_amdgcn_rsqf(ss * (1.f / 128.f) + EPS);
                        const float* og = KIN(I_SONG) + (l * 4 + g) * 128 + c0;
                        bf16_t* orow = OMIX + (size_t)(t0 + i) * D + 512 + g * 128 + c0;
#pragma unroll
                        for (int q = 0; q < 32; q += 2) *(unsigned*)(orow + q) = cvt_pk_bf16(a[q] * r * og[q], a[q + 1] * r * og[q + 1]);
                    }
                    __syncthreads();
                }
            }
#endif
        REP_END() }
        SEAM(pb + 1);

        if (IN(pb + 2)) { REP_BEGIN(pb + 2)
            PHASE_BEGIN();
            if (tid < 256) {
                for (int ei = bid * 256 + tid; ei < 65536; ei += G * 256) {
                    const int bh = ei >> 13, rem = ei & 8191, vd = rem >> 6, kd = rem & 63, b = bh >> 2, h = bh & 3;
                    float Sv = 0.f;
                    for (int n = 0; n < 128; n += 8) {
                        float dc[8], kv[8];
#pragma unroll
                        for (int q = 0; q < 8; ++q) { const int cn = b * 128 + n + q; dc[q] = DECAY[(size_t)(cn * 4 + h) * 64 + kd]; kv[q] = KVT[((size_t)(cn * 4 + h) * 128 + vd) * 64 + kd]; }
#pragma unroll
                        for (int q = 0; q < 8; ++q) { const int cn = b * 128 + n + q; ST[((size_t)(cn * 4 + h) * 128 + vd) * 64 + kd] = f2bf(Sv); Sv = dc[q] * Sv + kv[q]; }
                    }
                }
            }
        REP_END() }
        SEAM(pb + 2);
        if ((DUPMASK >> 13) & 1) { for (int _q = 0; _q < 4; ++_q) { KSEG_FENCE(); XcdBarrier _b; _b.bar = ctl + CW_BAR; _b.x = my_xcc; _b.st = MISC; xcd_barrier(_b); } }

        if (IN(pb + 3)) { REP_BEGIN(pb + 3)
            PHASE_BEGIN();
#if MFMA_G2
            {
                const int r32 = lane & 31, hf = lane >> 5;
                const int pr = (r32 & 19) | ((r32 & 4) << 1) | ((r32 & 8) >> 1);
                const float* ong = KIN(I_GONG) + l * 128 + 8 * hf;
                for (int task = gw; task < NCH * 4 * 2; task += NGW) {
                    const int unit = task >> 1, rt = task & 1, cn = unit >> 2, hh = unit & 3;
                    const bf16_t* Pc = P + (size_t)(cn * 64) * NP;
                    bf16x8 bq[4];
#pragma unroll
                    for (int ks = 0; ks < 4; ++ks) bq[ks] = *(const bf16x8*)(Pc + (size_t)(32 * rt + r32) * NP + PQ + hh * 64 + 16 * ks + 8 * hf);
                    f32x16 o[4];
#pragma unroll
                    for (int vt = 0; vt < 4; ++vt)
#pragma unroll
                        for (int r = 0; r < 16; ++r) o[vt][r] = 0.f;
                    const bf16_t* vtp = VT + ((size_t)unit * 128 + pr) * 64 + 8 * hf;
                    for (int jt = 0; jt <= rt; ++jt) {
                        f32x16 x;
#pragma unroll
                        for (int r = 0; r < 16; ++r) x[r] = 0.f;
#pragma unroll
                        for (int ks = 0; ks < 4; ++ks) { const bf16x8 ak = *(const bf16x8*)(Pc + (size_t)(32 * jt + pr) * NP + PK + hh * 64 + 16 * ks + 8 * hf); x = MFMA32(ak, bq[ks], x); }
                        if (jt == rt) {
#pragma unroll
                            for (int r = 0; r < 16; ++r) if (16 * (r >> 3) + 8 * hf + (r & 7) > r32) x[r] = 0.f;
                        }
#pragma unroll
                        for (int s = 0; s < 2; ++s) {
                            const bf16x8 xb = pack8(x[8 * s], x[8 * s + 1], x[8 * s + 2], x[8 * s + 3], x[8 * s + 4], x[8 * s + 5], x[8 * s + 6], x[8 * s + 7]);
#pragma unroll
                            for (int vt = 0; vt < 4; ++vt) { const bf16x8 av = *(const bf16x8*)(vtp + (size_t)(32 * vt) * 64 + 32 * jt + 16 * s); o[vt] = MFMA32(av, xb, o[vt]); }
                        }
                    }
                    const bf16_t* stp = ST + ((size_t)unit * 128 + pr) * 64 + 8 * hf;
#pragma unroll
                    for (int ks = 0; ks < 4; ++ks)
#pragma unroll
                        for (int vt = 0; vt < 4; ++vt) { const bf16x8 as = *(const bf16x8*)(stp + (size_t)(32 * vt) * 64 + 16 * ks); o[vt] = MFMA32(as, bq[ks], o[vt]); }
                    float ss = 0.f;
#pragma unroll
                    for (int vt = 0; vt < 4; ++vt)
#pragma unroll
                        for (int r = 0; r < 16; ++r) ss += o[vt][r] * o[vt][r];
                    ss += __shfl_xor(ss, 32);
                    const float rs = __builtin_amdgcn_rsqf(ss * (1.f / 128.f) + EPS);
                    const int t = cn * 64 + 32 * rt + r32;
                    const bf16_t* ogr = Pc + (size_t)(32 * rt + r32) * NP + POG + hh * 128 + 8 * hf;
                    bf16_t* orow = OMIX + (size_t)t * D + hh * 128 + 8 * hf;
#pragma unroll
                    for (int vt = 0; vt < 4; ++vt)
#pragma unroll
                        for (int g8 = 0; g8 < 2; ++g8) { const u32x4 gw4 = *(const u32x4*)(ogr + 32 * vt + 16 * g8); const f32x4 n0 = *(const f32x4*)(ong + 32 * vt + 16 * g8), n1 = *(const f32x4*)(ong + 32 * vt + 16 * g8 + 4);
                            *(bf16x8*)(orow + 32 * vt + 16 * g8) = pack8(o[vt][8 * g8] * rs * n0[0] * bflo(gw4[0]), o[vt][8 * g8 + 1] * rs * n0[1] * bfhi(gw4[0]), o[vt][8 * g8 + 2] * rs * n0[2] * bflo(gw4[1]), o[vt][8 * g8 + 3] * rs * n0[3] * bfhi(gw4[1]),
                                                                         o[vt][8 * g8 + 4] * rs * n1[0] * bflo(gw4[2]), o[vt][8 * g8 + 5] * rs * n1[1] * bfhi(gw4[2]), o[vt][8 * g8 + 6] * rs * n1[2] * bflo(gw4[3]), o[vt][8 * g8 + 7] * rs * n1[3] * bfhi(gw4[3])); }
                }
            }
#else
            LAS float* qd = (LAS float*)lds;
            LAS float* ki = (LAS float*)(lds + 16640);
            LAS float* vv = (LAS float*)(lds + 33280);
            LAS float* att = (LAS float*)(lds + 66048);
            LAS float* Sm = (LAS float*)(lds + 82688);
            LAS float* segtot = (LAS float*)(lds + 115456);
            const int col = tid & 63, seg = tid >> 6;
            const float* ong = KIN(I_GONG) + l * 128;
            for (int unit = bid; unit < NCH * 4; unit += G) {
                const int cn = unit >> 2, h = unit & 3;
                const bf16_t* Pc = P + (size_t)(cn * 64) * NP;
#pragma unroll
                for (int i = 0; i < 8; ++i) { const size_t ro = (size_t)(seg * 8 + i) * NP; qd[(seg * 8 + i) * 65 + col] = bf2f(Pc[ro + PQ + h * 64 + col]); ki[(seg * 8 + i) * 65 + col] = bf2f(Pc[ro + PK + h * 64 + col]); }
#pragma unroll
                for (int i = 0; i < 16; ++i) { const int idx = tid + 512 * i, p = idx >> 7, vd = idx & 127; vv[p * 128 + vd] = bf2f(Pc[(size_t)p * NP + PV + h * 128 + vd]); }
#pragma unroll
                for (int i = 0; i < 16; ++i) { const int idx = tid + 512 * i, vd = idx >> 6, kd = idx & 63; Sm[kd * 128 + vd] = bf2f(ST[((size_t)(cn * 4 + h) * 128 + vd) * 64 + kd]); }
                __syncthreads();
                {
                    const int i = tid >> 3, j0 = (tid & 7) * 8; float a[8];
#pragma unroll
                    for (int q = 0; q < 8; ++q) a[q] = 0.f;
                    for (int kd = 0; kd < 64; ++kd) { const float x = qd[i * 65 + kd];
#pragma unroll
                        for (int q = 0; q < 8; ++q) a[q] += x * ki[(j0 + q) * 65 + kd]; }
#pragma unroll
                    for (int q = 0; q < 8; ++q) att[i * 65 + j0 + q] = (j0 + q <= i) ? a[q] : 0.f;
                }
                __syncthreads();
                {
                    const int i = tid >> 3, v0 = (tid & 7) * 16; float a[16];
#pragma unroll
                    for (int q = 0; q < 16; ++q) a[q] = 0.f;
                    for (int j = 0; j <= i; ++j) { const float x = att[i * 65 + j];
#pragma unroll
                        for (int q = 0; q < 16; ++q) a[q] += x * vv[j * 128 + v0 + q]; }
                    for (int kd = 0; kd < 64; ++kd) { const float x = qd[i * 65 + kd];
#pragma unroll
                        for (int q = 0; q < 16; ++q) a[q] += x * Sm[kd * 128 + v0 + q]; }
                    float ss = 0.f;
#pragma unroll
                    for (int q = 0; q < 16; ++q) ss += a[q] * a[q];
                    ss += __shfl_xor(ss, 1); ss += __shfl_xor(ss, 2); ss += __shfl_xor(ss, 4);
                    const float r = __builtin_amdgcn_rsqf(ss * (1.f / 128.f) + EPS);
                    const int t = cn * 64 + i;
                    const bf16_t* ogr = P + (size_t)t * NP + POG + h * 128 + v0;
                    bf16_t* orow = OMIX + (size_t)t * D + h * 128 + v0;
#pragma unroll
                    for (int q = 0; q < 16; q += 2) *(unsigned*)(orow + q) = cvt_pk_bf16(a[q] * r * ong[v0 + q] * bf2f(ogr[q]), a[q + 1] * r * ong[v0 + q + 1] * bf2f(ogr[q + 1]));
                }
                __syncthreads();
            }
#endif
        REP_END() }
        SEAM(pb + 3);

        if (IN(pb + 4)) { REP_BEGIN(pb + 4)
            PHASE_BEGIN();
            pg8::DenseSched S; S.init(OMIX, WOUT + (size_t)l * D * D, T, D, G, bid);
            EpiOutProj E{l == 0 ? KIN(I_X) : XOUT, dry ? WSP(float, WS_DRY) : XOUT, modl + 2048};
            pg8::gemm_phase<EpiOutProj, pg8::DenseSched>(lds, tid, D, S, E);
        REP_END() }
        SEAM(pb + 4);

        if (IN(pb + 5)) { REP_BEGIN(pb + 5)
            PHASE_BEGIN();
            const size_t dro = 0; bf16_t* Hw = H;
            {
                LAS unsigned char* stg = lds + wave * 8704;
                LAS float* slab = (LAS float*)(lds + 69632);
                LAS float* ssl = (LAS float*)(lds + 69632 + 24576);
                LAS float* lgt = ssl + 128;
                LAS float* rl = lgt + 2560;
                LAS unsigned* lcnt = (LAS unsigned*)(rl + 64);
                LAS unsigned* lbase = lcnt + 32;
                unsigned* cntg = ctl + CW_CNT + l * 32 * 64 + (dry ? 32 : 0);
                if (tid < 32) lcnt[tid] = 0u;
                __syncthreads();
                const int half = lane >> 5, c4 = lane & 31, t16 = lane & 15, kq = lane >> 4;
                f16x8 bw[4][3];
                { const _Float16* wh = (const _Float16*)WRH + (size_t)l * 64 * D + (size_t)t16 * D + 128 * wave + 8 * kq;
#pragma unroll
                  for (int ks = 0; ks < 4; ++ks)
#pragma unroll
                      for (int nt = 0; nt < 3; ++nt) bw[ks][nt] = *(const f16x8*)(wh + (size_t)(16 * nt) * D + 32 * ks); }
                for (int task = bid; task < T / 64; task += G) {
                    const int t0 = task * 64, b = t0 >= SEQ ? 1 : 0;
                    const float* md = modl + (size_t)b * 6144 + 128 * wave + 4 * c4;
                    const f32x4 gg = *(const f32x4*)(KIN(I_N2G) + l * D + 128 * wave + 4 * c4), sc4 = *(const f32x4*)(md + 4096), sh4 = *(const f32x4*)(md + 3072);
                    const f32x4 cs4 = gg * (sc4 + 1.f);
                    const unsigned xoff = (unsigned)(half * D + 128 * wave + 4 * c4);
                    f32x4 xr[2][8]; u32x2 xh[4][8];
#pragma unroll
                    for (int s = 0; s < 2; ++s)
#pragma unroll
                        for (int i = 0; i < 8; ++i) { const float* rb = XOUT + (size_t)(t0 + 16 * s + 2 * i) * D; xr[s][i] = *(const f32x4*)(rb + xoff); }
#pragma unroll
                    for (int s = 0; s < 4; ++s) {
#pragma unroll
                        for (int i = 0; i < 8; ++i) {
                            f32x4 xv = xr[s & 1][i];
                            if (s < 2) { const float* rb = XOUT + (size_t)(t0 + 16 * (s + 2) + 2 * i) * D; xr[s & 1][i] = *(const f32x4*)(rb + xoff); }
                            float q = (xv[0] * xv[0] + xv[1] * xv[1]) + (xv[2] * xv[2] + xv[3] * xv[3]);
                            q += __shfl_xor(q, 1); q += __shfl_xor(q, 2); q += __shfl_xor(q, 4); q += __shfl_xor(q, 8); q += __shfl_xor(q, 16);
                            if (c4 == 0) ssl[wave * 16 + 2 * i + half] = q;
                            xv = xv * cs4;
                            u32x2 hi; hi.x = cvt_pk_f16(xv[0], xv[1]); hi.y = cvt_pk_f16(xv[2], xv[3]);
                            u32x2 lo; lo.x = cvt_pk_f16(xv[0] - h16lo(hi.x), xv[1] - h16hi(hi.x)); lo.y = cvt_pk_f16(xv[2] - h16lo(hi.y), xv[3] - h16hi(hi.y));
                            *(LAS u32x2*)(stg + (2 * i + half) * 272 + c4 * 8) = hi; *(LAS u32x2*)(stg + 4352 + (2 * i + half) * 272 + c4 * 8) = lo;
                            xh[s][i] = hi;
                        }
                        f32x4 acc[3];
#pragma unroll
                        for (int nt = 0; nt < 3; ++nt) acc[nt] = (f32x4){0.f, 0.f, 0.f, 0.f};
#pragma unroll
                        for (int ks = 0; ks < 4; ++ks) {
                            const f16x8 ah = *(const LAS f16x8*)(stg + t16 * 272 + (32 * ks + 8 * kq) * 2), al = *(const LAS f16x8*)(stg + 4352 + t16 * 272 + (32 * ks + 8 * kq) * 2);
#pragma unroll
                            for (int nt = 0; nt < 3; ++nt) {
                                acc[nt] = __builtin_amdgcn_mfma_f32_16x16x32_f16(ah, bw[ks][nt], acc[nt], 0, 0, 0);
                                acc[nt] = __builtin_amdgcn_mfma_f32_16x16x32_f16(al, bw[ks][nt], acc[nt], 0, 0, 0);
                            }
                        }
#pragma unroll
                        for (int nt = 0; nt < 3; ++nt)
#pragma unroll
                            for (int r = 0; r < 4; ++r) slab[(wave * 16 + 4 * kq + r) * 48 + 16 * nt + t16] = acc[nt][r];
                        __syncthreads();
                        {
                            const int tk = tid >> 5, sub = tid & 31;
                            float s8 = 0.f;
#pragma unroll
                            for (int w = 0; w < 8; ++w) s8 += ssl[w * 16 + tk];
                            const float r = __builtin_amdgcn_rsqf(s8 * (1.f / D) + EPS);
                            if (sub == 0) rl[16 * s + tk] = r;
                            { float a = 0.f;
#pragma unroll
                              for (int w = 0; w < 8; ++w) a += slab[(w * 16 + tk) * 48 + sub];
                              lgt[(16 * s + tk) * 40 + sub] = r * a + SHW[(l * 2 + b) * 64 + sub]; }
                            if (sub < 4) { float a = 0.f;
#pragma unroll
                              for (int w = 0; w < 8; ++w) a += slab[(w * 16 + tk) * 48 + 32 + sub];
                              lgt[(16 * s + tk) * 40 + 32 + sub] = r * a + SHW[(l * 2 + b) * 64 + 32 + sub]; }
                        }
                        __syncthreads();
                    }
                    int e1 = 0, e2 = 0, li1 = 0, li2 = 0; float w1 = 0.f, w2 = 0.f;
                    if (tid < 64) {
                        const LAS float* lg = lgt + tid * 40;
                        int gi = 0; float gm = lg[32];
#pragma unroll
                        for (int q = 1; q < 4; ++q) { const float v = lg[32 + q]; if (v > gm) { gm = v; gi = q; } }
                        float den = 0.f;
#pragma unroll
                        for (int q = 0; q < 4; ++q) den += __expf(lg[32 + q] - gm);
                        const float gwt = 1.f / den;
                        float el[8];
#pragma unroll
                        for (int q = 0; q < 8; ++q) el[q] = lg[gi * 8 + q];
                        int i1 = 0; float v1 = el[0];
#pragma unroll
                        for (int q = 1; q < 8; ++q) if (el[q] > v1) { v1 = el[q]; i1 = q; }
                        int i2 = -1; float v2 = -3.0e38f;
#pragma unroll
                        for (int q = 0; q < 8; ++q) if (q != i1 && el[q] > v2) { v2 = el[q]; i2 = q; }
                        const float ex = __expf(v2 - v1); w1 = gwt / (1.f + ex); w2 = gwt * ex / (1.f + ex);
                        e1 = gi * 8 + i1; e2 = gi * 8 + i2;
                        li1 = (int)atomicAdd((unsigned*)(lcnt + e1), 1u); li2 = (int)atomicAdd((unsigned*)(lcnt + e2), 1u);
                    }
                    __syncthreads();
                    if (tid < 32) { const unsigned n = lcnt[tid]; lbase[tid] = n ? atomicAdd(cntg + tid * 64, n) : 0u; lcnt[tid] = 0u; }
                    __syncthreads();
                    if (tid < 64) {
                        const int t = t0 + tid, s1 = (int)lbase[e1] + li1, s2 = (int)lbase[e2] + li2;
                        int* tokw = (int*)((char*)TOK + dro); float* wlw = (float*)((char*)WL + dro); int* refw = (int*)((char*)REF + dro);
                        tokw[(size_t)e1 * T + s1] = t; wlw[(size_t)e1 * T + s1] = w1; tokw[(size_t)e2 * T + s2] = t; wlw[(size_t)e2 * T + s2] = w2;
                        refw[2 * t] = (e1 << 16) | s1; refw[2 * t + 1] = (e2 << 16) | s2;
                    }
#pragma unroll
                    for (int s = 0; s < 4; ++s)
#pragma unroll
                        for (int i = 0; i < 8; ++i) {
                            const float r = rl[16 * s + 2 * i + half];
                            u32x2 o; o.x = cvt_pk_bf16(h16lo(xh[s][i].x) * r + sh4[0], h16hi(xh[s][i].x) * r + sh4[1]); o.y = cvt_pk_bf16(h16lo(xh[s][i].y) * r + sh4[2], h16hi(xh[s][i].y) * r + sh4[3]);
                            { bf16_t* hb = Hw + (size_t)(t0 + 16 * s + 2 * i) * D; *(u32x2*)(hb + xoff) = o; }
                        }
                    __syncthreads();
                }
            }
        REP_END() }
        SEAM(pb + 5);

#define MOE_TABLES(NSUB) do { __syncthreads(); if (tid < 32) TB_CNT[tid] = (int)__hip_atomic_load(ctl + CW_CNT + (l * 32 + tid) * 64, __ATOMIC_RELAXED, __HIP_MEMORY_SCOPE_AGENT); __syncthreads(); \
        if (tid == 0) { int _fp = 0, _bs = 0, _np = 0; for (int _e = 0; _e < 32; ++_e) { TB_TP[_e] = _fp; TB_BASE[_e] = _bs; _fp += TB_CNT[_e] >> 8; _np += (TB_CNT[_e] & 255) ? 1 : 0; _bs += TB_CNT[_e]; } TB_TP[32] = _fp; TB_TP[33] = _fp + _np; TB_BASE[32] = _bs; } __syncthreads(); \
        if (tid < 32) { const int _c = TB_CNT[tid], _nf = _c >> 8, _rm = _c & 255; for (int _m = 0; _m < _nf; ++_m) TB_TILE[TB_TP[tid] + _m] = (tid << 8) | _m; \
            if (_rm) { int _rk = 0; for (int _j = 0; _j < 32; ++_j) { const int _r2 = TB_CNT[_j] & 255; _rk += (_r2 > _rm || (_r2 == _rm && _j < tid)) ? 1 : 0; } TB_TILE[TB_TP[32] + _rk] = (tid << 8) | _nf; } } __syncthreads(); \
        if (tid < 16) { const int _L = tid * G + bid, _tile = _L / (NSUB); TB_UE[tid] = (_tile < TB_TP[33]) ? TB_TILE[_tile] : -1; } __syncthreads(); } while (0)

        if (IN(pb + 6)) { REP_BEGIN(pb + 6)
            PHASE_BEGIN();
            MOE_TABLES(2);
            MoeSched1 S{{TB_TP, TB_CNT, TB_BASE, TB_UE}, (const char*)H, (const char*)(WGU + (size_t)l * 32 * 512 * D), TOK, G, bid};
            EpiMoe1 E{ACT, WL};
            pg8::gemm_phase<EpiMoe1, MoeSched1>(lds, tid, D, S, E);
        REP_END() }
        SEAM(pb + 6);

        if (IN(pb + 7)) { REP_BEGIN(pb + 7)
            PHASE_BEGIN();
            MOE_TABLES(4);
            MoeSched2 S{{TB_TP, TB_CNT, TB_BASE, TB_UE}, (const char*)ACT, (const char*)(WD + (size_t)l * 32 * D * 256), nullptr, G, bid};
            EpiMoe2 E{Y};
            pg8::gemm_phase<EpiMoe2, MoeSched2>(lds, tid, 256, S, E);
        REP_END() }
        SEAM(pb + 7);

        if (IN(pb + 8)) { REP_BEGIN(pb + 8)
            PHASE_BEGIN();
            MOE_TABLES(1);
            constexpr int NTK = 4;
            for (int tb = gw * NTK; tb < T; tb += NGW * NTK) {
                const int b = tb >= SEQ ? 1 : 0;
                int rf[NTK][2];
#pragma unroll
                for (int k = 0; k < NTK; ++k) { rf[k][0] = REF[2 * (tb + k)]; rf[k][1] = REF[2 * (tb + k) + 1]; }
                const float* gt = modl + (size_t)b * 6144 + 5120;
                float* xw0 = dry ? WSP(float, WS_DRY) : XOUT; bf16_t* Hw = dry ? WSP(bf16_t, WS_DRY + 96 * MiB) : H;
                f32x4 v[NTK][4]; u32x2 ya[NTK][4], yc[NTK][4];
#pragma unroll
                for (int k = 0; k < NTK; ++k) {
                    const bf16_t* y1 = Y + (size_t)(TB_BASE[rf[k][0] >> 16] + (rf[k][0] & 0xffff)) * D; const bf16_t* y2 = Y + (size_t)(TB_BASE[rf[k][1] >> 16] + (rf[k][1] & 0xffff)) * D;
                    const float* xr = XOUT + (size_t)(tb + k) * D;
#pragma unroll
                    for (int j = 0; j < 4; ++j) { v[k][j] = *((const f32x4*)xr + lane + 64 * j); ya[k][j] = *((const u32x2*)y1 + lane + 64 * j); yc[k][j] = *((const u32x2*)y2 + lane + 64 * j); }
                }
                float rr[NTK];
#pragma unroll
                for (int k = 0; k < NTK; ++k) { float s = 0.f;
#pragma unroll
                    for (int j = 0; j < 4; ++j) { const f32x4 gg = *((const f32x4*)gt + lane + 64 * j);
                        f32x4 m; m.x = bflo(ya[k][j].x) + bflo(yc[k][j].x); m.y = bfhi(ya[k][j].x) + bfhi(yc[k][j].x); m.z = bflo(ya[k][j].y) + bflo(yc[k][j].y); m.w = bfhi(ya[k][j].y) + bfhi(yc[k][j].y);
                        v[k][j] = v[k][j] + gg * m; s += (v[k][j].x * v[k][j].x + v[k][j].y * v[k][j].y) + (v[k][j].z * v[k][j].z + v[k][j].w * v[k][j].w); }
                    rr[k] = __builtin_amdgcn_rsqf(wave_sum(s) * (1.f / D) + EPS); }
                if (l + 1 < DEPTH) {
                    const float* md = MOD + (size_t)((l + 1) * 2 + b) * 6144; const float* gp = KIN(I_N1G) + (l + 1) * D;
#pragma unroll
                    for (int j = 0; j < 4; ++j) {
                        const f32x4 g = *((const f32x4*)gp + lane + 64 * j), sc = *((const f32x4*)(md + 1024) + lane + 64 * j), sh = *((const f32x4*)md + lane + 64 * j);
                        const f32x4 cs = g * (sc + 1.f);
#pragma unroll
                        for (int k = 0; k < NTK; ++k) { *((f32x4*)(xw0 + (size_t)(tb + k) * D) + lane + 64 * j) = v[k][j];
                            const f32x4 hh = (v[k][j] * rr[k]) * cs + sh; u32x2 o; o.x = cvt_pk_bf16(hh.x, hh.y); o.y = cvt_pk_bf16(hh.z, hh.w); *((u32x2*)(Hw + (size_t)(tb + k) * D) + lane + 64 * j) = o; }
                    }
                } else {
#pragma unroll
                    for (int j = 0; j < 4; ++j) { const f32x4 g = *((const f32x4*)KIN(I_FING) + lane + 64 * j);
#pragma unroll
                        for (int k = 0; k < NTK; ++k) *((f32x4*)(xw0 + (size_t)(tb + k) * D) + lane + 64 * j) = (v[k][j] * rr[k]) * g; }
                }
            }
        REP_END() }
        SEAM(pb + 8);
    }
#undef IN
#undef SEAM
}

extern "C" void kernel_launch(void* const* d_in, const int* in_sizes, int n_in, void* d_out, int out_size, void* d_ws, size_t ws_size, hipStream_t stream) {
    static int grid = 0;
    if (grid == 0) {
        if (n_in != 24 || out_size != T * D || ws_size < WS_END) { fprintf(stderr, "kernel_launch: unexpected shapes (n_in %d, out %d, ws %zu)\n", n_in, out_size, ws_size); grid = -1; return; }
        int dev = 0, cus = 0, per_cu = 0;
        if (hipGetDevice(&dev) != hipSuccess || hipDeviceGetAttribute(&cus, hipDeviceAttributeMultiprocessorCount, dev) != hipSuccess) { grid = -1; return; }
        if (hipFuncSetAttribute((const void*)fwd_kernel, hipFuncAttributeMaxDynamicSharedMemorySize, LDS_BYTES) != hipSuccess) { fprintf(stderr, "kernel_launch: hipFuncSetAttribute failed\n"); grid = -1; return; }
        if (hipOccupancyMaxActiveBlocksPerMultiprocessor(&per_cu, (const void*)fwd_kernel, NWAVES * 64, LDS_BYTES) != hipSuccess || per_cu < 1) { fprintf(stderr, "kernel_launch: occupancy query says %d\n", per_cu); }
        (void)hipGetLastError();
        grid = cus;
    }
    if (grid < 0) return;
    if (hipMemsetAsync((char*)d_ws + WS_CTL, 0, CTL_ZERO_BYTES, stream) != hipSuccess) return;
    Args a{};
    for (int i = 0; i < 24; ++i) a.in[i] = (const float*)d_in[i];
    a.out = (float*)d_out; a.ws = (unsigned char*)d_ws;
#if MK_SPLIT
    for (int p = 0; p < NPH; ++p) { a.ph_lo = p; a.ph_hi = p + 1; hipLaunchKernelGGL(fwd_kernel, dim3(grid), dim3(NWAVES * 64), LDS_BYTES, stream, a); }
#else
    a.ph_lo = 0; a.ph_hi = NPH;
    hipLaunchKernelGGL(fwd_kernel, dim3(grid), dim3(NWAVES * 64), LDS_BYTES, stream, a);
#endif
}
```
